# Optimizing an MI355X kernel written in HIP

```python
import math
import jax, jax.numpy as jnp
from jax import lax
import numpy as np

D_MODEL = 1024
BATCH = 16
SEQ = 2048
DEPTH = 1

MEM_LEN = 256
A_HEADS = 8
A_HEAD_DIM = 64
A_WIDTH = A_HEADS * A_HEAD_DIM
MOBA_BLOCK = 256
MOBA_TOPK = 3
Q_BLOCK = 128
G_HEADS = 4
G_WIDTH = D_MODEL - A_WIDTH
G_HEAD_V = G_WIDTH // G_HEADS
G_KEY_WIDTH = G_WIDTH // 2
G_HEAD_K = G_KEY_WIDTH // G_HEADS
G_GATE_RANK = 16
G_GATE_NORM = 16.0
G_CHUNK = 64
MIX_WIDTH = A_WIDTH + G_WIDTH
IN_SPLITS = (A_WIDTH, A_WIDTH, A_WIDTH, G_KEY_WIDTH, G_KEY_WIDTH, G_WIDTH, G_GATE_RANK, G_WIDTH)
IN_COLS = 3 * A_WIDTH + 2 * G_KEY_WIDTH + G_WIDTH + G_GATE_RANK + G_WIDTH
X_HEADS = 4
X_HEAD_DIM = D_MODEL // X_HEADS
D_FF = 4 * D_MODEL
RP_BUCKETS = 32
RP_MAX_DIST = 128
EPS = 1e-6

kernel_name = "hybrid_moba_gla_xattn_block"


def rms_norm(x, g):
    xf = x.astype(jnp.float32)
    y = xf * lax.rsqrt(jnp.mean(xf * xf, axis=-1, keepdims=True) + EPS)
    return (y * g.astype(jnp.float32)).astype(x.dtype)


def rel_bucket(dist):
    max_exact = RP_BUCKETS // 2
    d = jnp.maximum(dist, 0)
    large = max_exact + (jnp.log(jnp.maximum(d, 1).astype(jnp.float32) / max_exact)
                         / math.log(RP_MAX_DIST / max_exact) * (RP_BUCKETS - max_exact)).astype(jnp.int32)
    large = jnp.minimum(large, RP_BUCKETS - 1)
    return jnp.where(d < max_exact, d, large)


def moba_attention(q, k, v, rp_table):
    B, T, H, dh = q.shape
    nb = -(-T // MOBA_BLOCK)
    pad = nb * MOBA_BLOCK - T
    kp = jnp.pad(k, ((0, 0), (0, pad), (0, 0), (0, 0)))
    vp = jnp.pad(v, ((0, 0), (0, pad), (0, 0), (0, 0)))
    kb = kp.reshape(B, nb, MOBA_BLOCK, H, dh).transpose(0, 3, 1, 2, 4)
    vb = vp.reshape(B, nb, MOBA_BLOCK, H, dh).transpose(0, 3, 1, 2, 4)
    nq = T // Q_BLOCK
    qc = q.reshape(B, nq, Q_BLOCK, H, dh).transpose(0, 1, 3, 2, 4).reshape(B * nq, H, Q_BLOCK, dh)
    scale = dh ** -0.5
    n_sel = min(MOBA_TOPK, nb - 1)
    table_t = rp_table.T.astype(jnp.float32)
    key_off = jnp.arange(MOBA_BLOCK, dtype=jnp.int32)
    hidx = jnp.arange(H)[:, None, None]
    b_ids = jnp.repeat(jnp.arange(B, dtype=jnp.int32), nq)
    qb_ids = jnp.tile(jnp.arange(nq, dtype=jnp.int32), B)
    xs = (qc, b_ids, qb_ids)
    if n_sel > 0:
        pos = jnp.arange(T, dtype=jnp.int32)
        q_blk = pos // MOBA_BLOCK
        kmean = jnp.mean(kb.astype(jnp.float32), axis=3)
        gate = jnp.einsum('bthd,bhnd->bhtn', q.astype(jnp.float32), kmean)
        past = jnp.arange(nb)[None, :] < q_blk[:, None]
        gate = jnp.where(past[None, None], gate, -jnp.inf)
        _, sel = lax.top_k(gate, n_sel)
        valid = sel < q_blk[None, None, :, None]
        sel_c = sel.reshape(B, H, nq, Q_BLOCK, n_sel).transpose(0, 2, 1, 3, 4).reshape(B * nq, H, Q_BLOCK, n_sel)
        valid_c = valid.reshape(B, H, nq, Q_BLOCK, n_sel).transpose(0, 2, 1, 3, 4).reshape(B * nq, H, Q_BLOCK, n_sel)
        xs = xs + (sel_c, valid_c)

    def step(args):
        qi, b, qb = args[0], args[1], args[2]
        kb_b = kb[b]
        vb_b = vb[b]
        q_pos = qb * Q_BLOCK + jnp.arange(Q_BLOCK, dtype=jnp.int32)
        own = (qb * Q_BLOCK) // MOBA_BLOCK
        k_own = lax.dynamic_index_in_dim(kb_b, own, axis=1, keepdims=False)
        v_own = lax.dynamic_index_in_dim(vb_b, own, axis=1, keepdims=False)
        d_own = q_pos[:, None] - (own * MOBA_BLOCK + key_off)[None, :]
        s_own = jnp.einsum('hqd,hld->hql', qi, k_own).astype(jnp.float32) * scale + table_t[:, rel_bucket(d_own)]
        s_own = jnp.where(d_own[None] >= 0, s_own, -jnp.inf)
        if n_sel > 0:
            sel_i, valid_i = args[3], args[4]
            k_sel = kb_b[hidx, sel_i]
            v_sel = vb_b[hidx, sel_i]
            d_sel = q_pos[None, :, None, None] - (sel_i[..., None] * MOBA_BLOCK + key_off)
            s_sel = (jnp.einsum('hqd,hqcld->hqcl', qi, k_sel).astype(jnp.float32) * scale
                     + table_t[hidx[..., None], rel_bucket(d_sel)])
            s_sel = jnp.where(valid_i[..., None], s_sel, -jnp.inf)
            s = jnp.concatenate([s_sel.reshape(H, Q_BLOCK, n_sel * MOBA_BLOCK), s_own], axis=-1)
            p = jax.nn.softmax(s, axis=-1).astype(v.dtype)
            p_sel = p[..., :n_sel * MOBA_BLOCK].reshape(H, Q_BLOCK, n_sel, MOBA_BLOCK)
            p_own = p[..., n_sel * MOBA_BLOCK:]
            return jnp.einsum('hqcl,hqcld->hqd', p_sel, v_sel) + jnp.einsum('hql,hld->hqd', p_own, v_own)
        p_own = jax.nn.softmax(s_own, axis=-1).astype(v.dtype)
        return jnp.einsum('hql,hld->hqd', p_own, v_own)

    o = lax.map(step, xs)
    return o.reshape(B, nq, H, Q_BLOCK, dh).transpose(0, 1, 3, 2, 4).reshape(B, T, H * dh)


def gla_chunked(q, k, v, log_a):
    B, T, H, dk = q.shape
    dv = v.shape[-1]
    nc = T // G_CHUNK
    scale = dk ** -0.5

    def to_chunks(t):
        return t.reshape(B, nc, G_CHUNK, H, t.shape[-1]).transpose(1, 0, 3, 2, 4)

    causal = jnp.tril(jnp.ones((G_CHUNK, G_CHUNK), dtype=bool))

    def body(S, inp):
        qi, ki, vi, gi = inp
        qf = qi.astype(jnp.float32) * scale
        kf = ki.astype(jnp.float32)
        vf = vi.astype(jnp.float32)
        b = jnp.cumsum(gi.astype(jnp.float32), axis=2)
        o_inter = jnp.einsum('bhcd,bhde->bhce', qf * jnp.exp(b), S)
        diff = b[:, :, :, None, :] - b[:, :, None, :, :]
        decay = jnp.exp(jnp.where(causal[None, None, :, :, None], diff, -jnp.inf))
        A = jnp.einsum('bhid,bhjd,bhijd->bhij', qf, kf, decay)
        o_intra = jnp.einsum('bhij,bhje->bhie', A, vf)
        b_last = b[:, :, -1:, :]
        S_new = jnp.exp(b_last[:, :, 0, :])[..., None] * S + jnp.einsum('bhcd,bhce->bhde', kf * jnp.exp(b_last - b), vf)
        return S_new, o_inter + o_intra

    S0 = jnp.zeros((B, H, dk, dv), jnp.float32)
    _, o = lax.scan(body, S0, (to_chunks(q), to_chunks(k), to_chunks(v), to_chunks(log_a)))
    return o.transpose(1, 0, 3, 2, 4).reshape(B, T, H, dv).astype(v.dtype)


def setup_inputs(seed: int = 0) -> dict:
    key = jax.random.key(seed)
    ks = jax.random.split(key, 20)

    def nrm(k, shape, scale):
        return jax.random.normal(k, shape, jnp.float32) * scale

    def gain(k, shape):
        return 1.0 + 0.05 * jax.random.normal(k, shape, jnp.float32)

    L = DEPTH
    return {
        "x": nrm(ks[0], (BATCH, SEQ, D_MODEL), 1.0),
        "mem": nrm(ks[1], (BATCH, MEM_LEN, D_MODEL), 1.0),
        "rp_table": nrm(ks[2], (RP_BUCKETS, A_HEADS), 0.5),
        "norm_mix": gain(ks[3], (L, D_MODEL)),
        "w_in": nrm(ks[4], (L, D_MODEL, IN_COLS), D_MODEL ** -0.5),
        "w_gate_up": nrm(ks[5], (L, G_GATE_RANK, G_KEY_WIDTH), G_GATE_RANK ** -0.5),
        "b_gate": nrm(ks[6], (L, G_KEY_WIDTH), 0.1),
        "g_norm": gain(ks[7], (L, G_HEAD_V)),
        "w_out": nrm(ks[8], (L, MIX_WIDTH, D_MODEL), MIX_WIDTH ** -0.5),
        "norm_xattn": gain(ks[9], (L, D_MODEL)),
        "norm_mem": gain(ks[10], (L, D_MODEL)),
        "w_xq": nrm(ks[11], (L, D_MODEL, D_MODEL), D_MODEL ** -0.5),
        "w_xkv": nrm(ks[12], (L, D_MODEL, 2 * D_MODEL), D_MODEL ** -0.5),
        "w_xo": nrm(ks[13], (L, D_MODEL, D_MODEL), D_MODEL ** -0.5),
        "norm_mlp": gain(ks[14], (L, D_MODEL)),
        "w_up": nrm(ks[15], (L, D_MODEL, D_FF), D_MODEL ** -0.5),
        "w_down": nrm(ks[16], (L, D_FF, D_MODEL), D_FF ** -0.5),
        "norm_final": gain(ks[17], (D_MODEL,)),
    }


def reference(x, mem, rp_table, norm_mix, w_in, w_gate_up, b_gate, g_norm, w_out,
              norm_xattn, norm_mem, w_xq, w_xkv, w_xo, norm_mlp, w_up, w_down, norm_final):
    B, T, _ = x.shape
    M = mem.shape[1]
    offsets = [int(o) for o in np.cumsum(IN_SPLITS)[:-1]]
    for l in range(DEPTH):
        h = rms_norm(x, norm_mix[l])
        proj = h @ w_in[l]
        qa, ka, va, qg, kg, vg, glr, rg = jnp.split(proj, offsets, axis=-1)
        o_a = moba_attention(qa.reshape(B, T, A_HEADS, A_HEAD_DIM),
                             ka.reshape(B, T, A_HEADS, A_HEAD_DIM),
                             va.reshape(B, T, A_HEADS, A_HEAD_DIM), rp_table)
        log_a = jax.nn.log_sigmoid((glr @ w_gate_up[l] + b_gate[l]).astype(jnp.float32)) / G_GATE_NORM
        o_g = gla_chunked(qg.reshape(B, T, G_HEADS, G_HEAD_K),
                          kg.reshape(B, T, G_HEADS, G_HEAD_K),
                          vg.reshape(B, T, G_HEADS, G_HEAD_V),
                          log_a.reshape(B, T, G_HEADS, G_HEAD_K))
        o_g = rms_norm(o_g, g_norm[l]).reshape(B, T, G_WIDTH) * jax.nn.silu(rg)
        x = x + jnp.concatenate([o_a, o_g], axis=-1) @ w_out[l]
        h = rms_norm(x, norm_xattn[l])
        m = rms_norm(mem, norm_mem[l])
        qx = (h @ w_xq[l]).reshape(B, T, X_HEADS, X_HEAD_DIM)
        kx, vx = jnp.split(m @ w_xkv[l], 2, axis=-1)
        kx = kx.reshape(B, M, X_HEADS, X_HEAD_DIM)
        vx = vx.reshape(B, M, X_HEADS, X_HEAD_DIM)
        s = jnp.einsum('bthd,bmhd->bhtm', qx, kx).astype(jnp.float32) * (X_HEAD_DIM ** -0.5)
        p = jax.nn.softmax(s, axis=-1).astype(vx.dtype)
        ox = jnp.einsum('bhtm,bmhd->bthd', p, vx).reshape(B, T, D_MODEL)
        x = x + ox @ w_xo[l]
        h = rms_norm(x, norm_mlp[l])
        x = x + jnp.square(jax.nn.relu(h @ w_up[l])) @ w_down[l]
    return rms_norm(x, norm_final)
```

```cpp
#include <hip/hip_runtime.h>
#include <cstdio>
#include <cstdint>
#include <cmath>
namespace pg8 {
#define PG8_LAS __attribute__((address_space(3)))
typedef unsigned short bf16_t;
typedef short bf16x8 __attribute__((ext_vector_type(8)));
typedef float f32x4 __attribute__((ext_vector_type(4)));
typedef unsigned u32x4 __attribute__((ext_vector_type(4)));
constexpr int BM = 256, BK = 64, HALF = 128, HTB = HALF * BK * 2  , STAGE_BYTES = 8 * HTB, NXCD = 8, WGM = 8;

__host__ __device__ __forceinline__ int lds_byte(int r, int c) { const int st = (r >> 4) * 2 + (c >> 5), rr = r & 15, cc = c & 31, ob = rr * 64 + cc * 2; return st * 1024 + (ob ^ (((ob >> 9) & 1) << 5)); }
__host__ __device__ __forceinline__ void stage_rc(int b, int& R, int& C) { const int st = b / 1024, sb = b % 1024, swz = sb ^ (((sb >> 9) & 1) << 5); R = (st >> 1) * 16 + swz / 64; C = (st & 1) * 32 + (swz % 64) / 2; }
__host__ __device__ __forceinline__ int perm32(int rho) { const int n = rho >> 4, i = rho & 15; return 8 * (i >> 2) + 4 * n + (i & 3); }

struct Unit { int pm, pn; };
struct Gemm { const bf16_t* A; const bf16_t* Bt; int M, N, K; };

struct StaticOrder {
    int nM, nN, nwg, G, c;
    __host__ __device__ void init(int M, int N, int G_, int c_) { nM = M / BM; nN = N / BM; nwg = nM * nN; G = G_; c = c_; }
    __host__ __device__ bool next(int i, Unit& u) const {
        const long L = (long)i * G + c; if (L >= nwg) return false;
        int wgid = (int)L; { const int q = nwg / NXCD, r = nwg % NXCD, xcd = wgid % NXCD, off = wgid / NXCD; wgid = (xcd < r ? xcd * (q + 1) : r * (q + 1) + (xcd - r) * q) + off; }
        const int nig = WGM * nN, gid = wgid / nig, fm = gid * WGM, gsz = (nM - fm) < WGM ? (nM - fm) : WGM;
        u.pm = fm + ((wgid % nig) % gsz); u.pn = (wgid % nig) / gsz; return true;
    }
    __device__ __forceinline__ void a_ready(const Unit&) const {}
    __device__ __forceinline__ void done(const Unit&) const {}
};
__device__ __forceinline__ unsigned cvt_pk_bf16(float lo, float hi) { unsigned r; asm volatile("v_cvt_pk_bf16_f32 %0, %1, %2" : "=v"(r) : "v"(lo), "v"(hi)); return r; }
typedef float f32x2 __attribute__((ext_vector_type(2)));
typedef unsigned u32x2e __attribute__((ext_vector_type(2)));
__device__ __forceinline__ u32x4 pack8(f32x4 v0, f32x4 v1) { u32x4 w; w.x = cvt_pk_bf16(v0[0], v0[1]); w.y = cvt_pk_bf16(v0[2], v0[3]); w.z = cvt_pk_bf16(v1[0], v1[1]); w.w = cvt_pk_bf16(v1[2], v1[3]); return w; }

struct EpiInProj {
    static constexpr bool PERM = true, AFTER_DRAIN = false;
    bf16_t *qa, *ka, *va, *qg, *kg, *vg, *rg; float* glr; float* ksum; float qa_scale, qg_scale;
    __device__ __forceinline__ void operator()(const f32x4 (&acc)[2][2][4][2], const Unit& u, int wr, int wc, int fr, int fq) const {
        const int pn = u.pn; const int row0 = u.pm * BM + wr * 64 + fr; const int cin = wc * 32 + 8 * fq;
        if (pn == 12) {
            if (wc == 0 && fq < 2) {
#pragma unroll
                for (int ai = 0; ai < 2; ++ai)
#pragma unroll
                    for (int m = 0; m < 4; ++m) { float* p = glr + (size_t)(row0 + ai * HALF + m * 16) * 16 + 8 * fq; *(f32x4*)p = acc[ai][0][m][0]; *(f32x4*)(p + 4) = acc[ai][0][m][1]; }
            }
            return;
        }
        bf16_t* base; int pitch, coff; float sc = 1.f;
        if (pn < 2) { base = qa; pitch = 512; coff = pn * 256; sc = qa_scale; }
        else if (pn < 4) { base = ka; pitch = 512; coff = (pn - 2) * 256; }
        else if (pn < 6) { base = va; pitch = 512; coff = (pn - 4) * 256; }
        else if (pn == 6) { base = qg; pitch = 256; coff = 0; sc = qg_scale; }
        else if (pn == 7) { base = kg; pitch = 256; coff = 0; }
        else if (pn < 10) { base = vg; pitch = 512; coff = (pn - 8) * 256; }
        else { base = rg; pitch = 512; coff = (pn - 10) * 256; }
#pragma unroll
        for (int ai = 0; ai < 2; ++ai)
#pragma unroll
            for (int m = 0; m < 4; ++m) { bf16_t* rowp = base + (size_t)(row0 + ai * HALF + m * 16) * pitch + coff + cin;
#pragma unroll
                for (int bj = 0; bj < 2; ++bj) *(u32x4*)(rowp + bj * HALF) = pack8(acc[ai][bj][m][0] * sc, acc[ai][bj][m][1] * sc); }
        if (pn == 2 || pn == 3) {
            float* kp = ksum + (size_t)u.pm * 512 + (pn - 2) * 256 + cin;
#pragma unroll
            for (int bj = 0; bj < 2; ++bj) {
                f32x4 s0 = {0.f, 0.f, 0.f, 0.f}, s1 = {0.f, 0.f, 0.f, 0.f};
#pragma unroll
                for (int ai = 0; ai < 2; ++ai)
#pragma unroll
                    for (int m = 0; m < 4; ++m) { s0 += acc[ai][bj][m][0]; s1 += acc[ai][bj][m][1]; }
#pragma unroll
                for (int e = 0; e < 4; ++e) {
#pragma unroll
                    for (int o = 1; o < 16; o <<= 1) { s0[e] += __shfl_xor(s0[e], o); s1[e] += __shfl_xor(s1[e], o); }
                }
                if (fr == 0) {
#pragma unroll
                    for (int e = 0; e < 4; ++e) { atomicAdd(kp + bj * HALF + e, s0[e]); atomicAdd(kp + bj * HALF + 4 + e, s1[e]); }
                }
            }
        }
    }
};

struct EpiSplitBf16 {
    static constexpr bool PERM = true, AFTER_DRAIN = false;
    bf16_t *o0, *o1; int split_tiles; int pitch;
    __device__ __forceinline__ void operator()(const f32x4 (&acc)[2][2][4][2], const Unit& u, int wr, int wc, int fr, int fq) const {
        const int row0 = u.pm * BM + wr * 64 + fr; const int t = u.pn >= split_tiles ? 1 : 0;
        bf16_t* base = t ? o1 : o0; const int col0 = (u.pn - t * split_tiles) * BM + wc * 32 + 8 * fq;
#pragma unroll
        for (int ai = 0; ai < 2; ++ai)
#pragma unroll
            for (int m = 0; m < 4; ++m) { bf16_t* rowp = base + (size_t)(row0 + ai * HALF + m * 16) * pitch + col0;
#pragma unroll
                for (int bj = 0; bj < 2; ++bj) *(u32x4*)(rowp + bj * HALF) = pack8(acc[ai][bj][m][0], acc[ai][bj][m][1]); }
    }
};

template <bool WITH_AN> struct EpiResidual {
    static constexpr bool PERM = true, AFTER_DRAIN = false;
    const float* xb; float* xo; bf16_t* an; const float* gain; float* ssq;
    __device__ __forceinline__ void operator()(const f32x4 (&acc)[2][2][4][2], const Unit& u, int wr, int wc, int fr, int fq) const {
        const int row0 = u.pm * BM + wr * 64 + fr; const int col0 = u.pn * BM + wc * 32 + 8 * fq;
        f32x4 g[2][2];
        if (WITH_AN) {
#pragma unroll
            for (int bj = 0; bj < 2; ++bj) { g[bj][0] = *(const f32x4*)(gain + col0 + bj * HALF); g[bj][1] = *(const f32x4*)(gain + col0 + bj * HALF + 4); }
        }
#pragma unroll
        for (int ai = 0; ai < 2; ++ai)
#pragma unroll
            for (int m = 0; m < 4; ++m) { const int row = row0 + ai * HALF + m * 16; const size_t off = (size_t)row * 1024 + col0; float sq = 0.f;
#pragma unroll
                for (int bj = 0; bj < 2; ++bj) {
                    const f32x4 b0 = *(const f32x4*)(xb + off + bj * HALF), b1 = *(const f32x4*)(xb + off + bj * HALF + 4);
                    const f32x4 v0 = b0 + acc[ai][bj][m][0], v1 = b1 + acc[ai][bj][m][1];
                    *(f32x4*)(xo + off + bj * HALF) = v0; *(f32x4*)(xo + off + bj * HALF + 4) = v1;
                    sq += (v0[0] * v0[0] + v0[1] * v0[1]) + (v0[2] * v0[2] + v0[3] * v0[3]) + (v1[0] * v1[0] + v1[1] * v1[1]) + (v1[2] * v1[2] + v1[3] * v1[3]);
                    if (WITH_AN) *(u32x4*)(an + off + bj * HALF) = pack8(v0 * g[bj][0], v1 * g[bj][1]);
                }
                sq += __shfl_xor(sq, 16); sq += __shfl_xor(sq, 32);
                if (fq == 0) atomicAdd(ssq + row, sq);
            }
    }
};

template <int ACT> struct EpiRowScale {
    static constexpr bool PERM = true, AFTER_DRAIN = false;
    bf16_t* out; int pitch; const float* ssq; float eps, scale;
    __device__ __forceinline__ void operator()(const f32x4 (&acc)[2][2][4][2], const Unit& u, int wr, int wc, int fr, int fq) const {
        const int row0 = u.pm * BM + wr * 64 + fr; const int col0 = u.pn * BM + wc * 32 + 8 * fq;
#pragma unroll
        for (int ai = 0; ai < 2; ++ai)
#pragma unroll
            for (int m = 0; m < 4; ++m) { const int row = row0 + ai * HALF + m * 16; const float rs = __builtin_amdgcn_rsqf(ssq[row] * (1.0f / 1024.0f) + eps) ;
                bf16_t* rowp = out + (size_t)row * pitch + col0;
#pragma unroll
                for (int bj = 0; bj < 2; ++bj) { f32x4 v0 = acc[ai][bj][m][0] * rs, v1 = acc[ai][bj][m][1] * rs;
                    if (ACT == 1) {
#pragma unroll
                        for (int e = 0; e < 4; ++e) { const float a = fmaxf(v0[e], 0.f), b = fmaxf(v1[e], 0.f); v0[e] = a * a; v1[e] = b * b; }
                    }
                    *(u32x4*)(rowp + bj * HALF) = pack8(v0 * scale, v1 * scale); }
            }
    }
};
template <class Epi, class Sched, bool ALIGN_EPI = false, bool SP2 = false>
__device__ __forceinline__ void gemm_phase(PG8_LAS unsigned char* lds, const Gemm g, const Sched& S, const Epi& E) {
    const int tid = threadIdx.x, wid = __builtin_amdgcn_readfirstlane(tid >> 6), lane = tid & 63, wr = wid >> 2, wc = wid & 3, fr = lane & 15, fq = lane >> 4;
    const int K = g.K, nt = K / BK;
    unsigned voffA[2], voffB[2];
#pragma unroll
    for (int i = 0; i < 2; ++i) { int R, C; stage_rc(tid * 16 + i * 8192, R, C); const int Rb = Epi::PERM ? ((R & ~31) + perm32(R & 31)) : R;
        voffA[i] = (unsigned)(R * K + C) * 2u; voffB[i] = (unsigned)(Rb * K + C) * 2u; }
    const size_t kstep = (size_t)(BK * 2);
    const size_t hstep = (size_t)HALF * K * 2;
    const size_t tstep = 2 * hstep;
    const unsigned ldsw = (unsigned)wid * 1024u;
    const int aoff = lds_byte(wr * 64 + fr, fq * 8), boff = lds_byte(wc * 32 + fr, fq * 8);
#define PG8_SA(b, h) (((b) * 2 + (h)) * HTB)
#define PG8_SB(b, h) ((4 + (b) * 2 + (h)) * HTB)
#define PG8_STAGE(bufoff, gbase, voff) do { _Pragma("unroll") for (int _i = 0; _i < 2; ++_i) \
        __builtin_amdgcn_global_load_lds((const unsigned*)((const char*)(gbase) + (voff)[_i]), (PG8_LAS unsigned*)(lds + (bufoff) + ldsw + _i * 8192), 16, 0, 0); } while (0)
#define PG8_LDA(dst, b, h) do { _Pragma("unroll") for (int m = 0; m < 4; ++m) _Pragma("unroll") for (int k = 0; k < 2; ++k) dst[m][k] = *(const PG8_LAS bf16x8*)(lds + PG8_SA(b, h) + aoff + m * 2048 + k * 1024); } while (0)
#define PG8_LDB(dst, b, h) do { _Pragma("unroll") for (int n = 0; n < 2; ++n) _Pragma("unroll") for (int k = 0; k < 2; ++k) dst[n][k] = *(const PG8_LAS bf16x8*)(lds + PG8_SB(b, h) + boff + n * 2048 + k * 1024); } while (0)
#define PG8_MMA(ai, bj, At, Bt) do { __builtin_amdgcn_s_setprio(1); _Pragma("unroll") for (int m = 0; m < 4; ++m) _Pragma("unroll") for (int n = 0; n < 2; ++n) _Pragma("unroll") for (int k = 0; k < 2; ++k) \
        acc[ai][bj][m][n] = __builtin_amdgcn_mfma_f32_16x16x32_bf16(Bt[n][k], At[m][k], acc[ai][bj][m][n], 0, 0, 0); __builtin_amdgcn_s_setprio(0); } while (0)
#define PG8_WAIT_V(n) asm volatile("s_waitcnt vmcnt(" #n ")" ::: "memory")
#define PG8_WAIT_L(n) asm volatile("s_waitcnt lgkmcnt(" #n ")" ::: "memory")
#define PG8_BAR __builtin_amdgcn_s_barrier()
#define PG8_SCHED __builtin_amdgcn_sched_barrier(0)
    Unit cur, nxt; int ui = 0;
    if (!S.next(0, cur)) return;
    f32x4 acc[2][2][4][2];
#pragma unroll
    for (int a = 0; a < 2; ++a)
#pragma unroll
        for (int b = 0; b < 2; ++b)
#pragma unroll
            for (int m = 0; m < 4; ++m)
#pragma unroll
                for (int n = 0; n < 2; ++n) acc[a][b][m][n] = (f32x4){0.f, 0.f, 0.f, 0.f};
    bf16x8 At[4][2], B0[2][2], B1[2][2];
    const char* cA = (const char*)g.A + (size_t)cur.pm * tstep; const char* cB = (const char*)g.Bt + (size_t)cur.pn * tstep;
    S.a_ready(cur);
    if constexpr (SP2) {
        PG8_STAGE(PG8_SB(0, 0), cB, voffB); PG8_STAGE(PG8_SB(0, 1), cB + hstep, voffB); PG8_STAGE(PG8_SA(0, 0), cA, voffA); PG8_STAGE(PG8_SA(0, 1), cA + hstep, voffA);
        if (wr == 1) PG8_BAR;
        PG8_WAIT_V(2); PG8_BAR;
        PG8_STAGE(PG8_SB(1, 0), cB + kstep, voffB); PG8_STAGE(PG8_SA(1, 0), cA + kstep, voffA); PG8_STAGE(PG8_SB(1, 1), cB + hstep + kstep, voffB);
        PG8_WAIT_V(6); PG8_BAR;
    } else {
        PG8_STAGE(PG8_SB(0, 0), cB, voffB); PG8_STAGE(PG8_SA(0, 0), cA, voffA); PG8_STAGE(PG8_SB(0, 1), cB + hstep, voffB); PG8_STAGE(PG8_SA(0, 1), cA + hstep, voffA);
        if (wr == 1) PG8_BAR;
        PG8_WAIT_V(4); PG8_BAR;
        PG8_STAGE(PG8_SB(1, 0), cB + kstep, voffB); PG8_STAGE(PG8_SA(1, 0), cA + kstep, voffA); PG8_STAGE(PG8_SB(1, 1), cB + hstep + kstep, voffB);
        PG8_WAIT_V(6); PG8_BAR;
    }
    for (;;) {
        const bool has_next = S.next(ui + 1, nxt);
        const char* nA = has_next ? (const char*)g.A + (size_t)nxt.pm * tstep : cA; const char* nB = has_next ? (const char*)g.Bt + (size_t)nxt.pn * tstep : cB;
        for (int t = 0; t < nt; t += 2) {
            const bool last = (t == nt - 2);
            const char* a1 = cA + (size_t)(t + 1) * kstep;
            const char* a2 = last ? nA : cA + (size_t)(t + 2) * kstep; const char* b2 = last ? nB : cB + (size_t)(t + 2) * kstep;
            const char* a3 = a2 + kstep; const char* b3 = b2 + kstep;
            if (last && has_next) S.a_ready(nxt);
            if constexpr (SP2) {
            PG8_LDB(B0, 0, 0); PG8_LDB(B1, 0, 1); PG8_SCHED; PG8_LDA(At, 0, 0); PG8_STAGE(PG8_SA(1, 1), a1 + hstep, voffA);
            PG8_WAIT_V(8); PG8_WAIT_L(0); PG8_BAR; PG8_MMA(0, 0, At, B0); PG8_MMA(0, 1, At, B1); PG8_BAR; PG8_SCHED;
            PG8_LDA(At, 0, 1); PG8_STAGE(PG8_SB(0, 0), b2, voffB); PG8_STAGE(PG8_SB(0, 1), b2 + hstep, voffB); PG8_STAGE(PG8_SA(0, 0), a2, voffA);
            PG8_WAIT_V(8); PG8_WAIT_L(0); PG8_BAR; PG8_MMA(1, 0, At, B0); PG8_MMA(1, 1, At, B1); PG8_BAR; PG8_SCHED;
            PG8_LDB(B0, 1, 0); PG8_LDB(B1, 1, 1); PG8_SCHED; PG8_LDA(At, 1, 0); PG8_STAGE(PG8_SA(0, 1), a2 + hstep, voffA);
            PG8_WAIT_V(8); PG8_WAIT_L(0); PG8_BAR; PG8_MMA(0, 0, At, B0); PG8_MMA(0, 1, At, B1); PG8_BAR; PG8_SCHED;
            PG8_LDA(At, 1, 1); PG8_STAGE(PG8_SB(1, 0), b3, voffB); PG8_STAGE(PG8_SB(1, 1), b3 + hstep, voffB); PG8_STAGE(PG8_SA(1, 0), a3, voffA);
            PG8_WAIT_V(8); PG8_WAIT_L(0); PG8_BAR; PG8_MMA(1, 0, At, B0); PG8_MMA(1, 1, At, B1); PG8_BAR; PG8_SCHED;
            } else {
            PG8_LDB(B0, 0, 0); PG8_SCHED; PG8_LDA(At, 0, 0); PG8_STAGE(PG8_SA(1, 1), a1 + hstep, voffA);
            PG8_WAIT_L(8); PG8_BAR; PG8_WAIT_L(0); PG8_MMA(0, 0, At, B0); PG8_BAR; PG8_SCHED;
            PG8_LDB(B1, 0, 1); PG8_STAGE(PG8_SB(0, 0), b2, voffB);
            PG8_BAR; PG8_WAIT_L(0); PG8_MMA(0, 1, At, B1); PG8_BAR;
            PG8_LDA(At, 0, 1); PG8_STAGE(PG8_SA(0, 0), a2, voffA);
            PG8_BAR; PG8_WAIT_L(0); PG8_MMA(1, 0, At, B0); PG8_BAR; PG8_SCHED;
            PG8_STAGE(PG8_SB(0, 1), b2 + hstep, voffB);
            PG8_WAIT_V(6); PG8_BAR; PG8_MMA(1, 1, At, B1); PG8_BAR;
            PG8_LDB(B0, 1, 0); PG8_SCHED; PG8_LDA(At, 1, 0); PG8_STAGE(PG8_SA(0, 1), a2 + hstep, voffA);
            PG8_WAIT_L(8); PG8_BAR; PG8_WAIT_L(0); PG8_MMA(0, 0, At, B0); PG8_BAR; PG8_SCHED;
            PG8_LDB(B1, 1, 1); PG8_STAGE(PG8_SB(1, 0), b3, voffB);
            PG8_BAR; PG8_WAIT_L(0); PG8_MMA(0, 1, At, B1); PG8_BAR;
            PG8_LDA(At, 1, 1); PG8_STAGE(PG8_SA(1, 0), a3, voffA);
            PG8_BAR; PG8_WAIT_L(0); PG8_MMA(1, 0, At, B0); PG8_BAR; PG8_SCHED;
            PG8_STAGE(PG8_SB(1, 1), b3 + hstep, voffB);
            PG8_WAIT_V(6); PG8_BAR; PG8_MMA(1, 1, At, B1); PG8_BAR;
            }
        }
        if constexpr (ALIGN_EPI) { if (wr == 0) PG8_BAR; }
        if constexpr (!Epi::AFTER_DRAIN) { E(acc, cur, wr, wc, fr, fq); S.done(cur); }
        if (!has_next) break;
#pragma unroll
        for (int a = 0; a < 2; ++a)
#pragma unroll
            for (int b = 0; b < 2; ++b)
#pragma unroll
                for (int m = 0; m < 4; ++m)
#pragma unroll
                    for (int n = 0; n < 2; ++n) acc[a][b][m][n] = (f32x4){0.f, 0.f, 0.f, 0.f};
        cur = nxt; cA = nA; cB = nB; ++ui;
        if constexpr (ALIGN_EPI) { if (wr == 1) PG8_BAR; }
    }
    PG8_WAIT_V(0);
    if constexpr (!ALIGN_EPI) { if (wr == 0) PG8_BAR; }
    PG8_BAR;
    if constexpr (Epi::AFTER_DRAIN) { E.fused(acc, cur, wr, wc, fr, fq, lds, wid, lane); S.done(cur); }
#undef PG8_SA
#undef PG8_SB
#undef PG8_STAGE
#undef PG8_LDA
#undef PG8_LDB
#undef PG8_MMA
#undef PG8_WAIT_V
#undef PG8_WAIT_L
#undef PG8_BAR
#undef PG8_SCHED
}
}
#define PG8_SP2 true
#define PG8_ALIGN true

constexpr int NWAVES = 8;
constexpr int BATCH = 16, SEQ = 2048, DM = 1024, M = BATCH * SEQ;
constexpr int MEMLEN = 256, MM = BATCH * MEMLEN;
constexpr int AH = 8, AHD = 64, AW = 512, NBLK = SEQ / 256;
constexpr int GH = 4, GHK = 64, GHV = 128, GKW = 256, GW = 512, GRANK = 16;
constexpr int XH = 4, XHD = 256;
constexpr int FF = 4096;
constexpr int NIN = 3328;
constexpr float EPS = 1e-6f;
constexpr float LOG2E = 1.4426950408889634f;
constexpr float C2A = 0.125f * LOG2E;
constexpr float C2X = 0.0625f * LOG2E;

constexpr size_t MiB = 1u << 20;
constexpr size_t WS_CTL = 0, CTL_ZERO_BYTES = 256 * 1024;
constexpr size_t WS_SSQ1 = 1 * MiB, WS_SSQ2 = WS_SSQ1 + 128 * 1024, WS_SSQ3 = WS_SSQ2 + 128 * 1024;
constexpr size_t WS_KSUM = WS_SSQ3 + 128 * 1024;
constexpr size_t WS_BIAS = WS_KSUM + 256 * 1024;
constexpr size_t WS_WIN = 2 * MiB, WS_WOUT = 9 * MiB, WS_WXQ = 11 * MiB, WS_WXKV = 13 * MiB, WS_WXO = 17 * MiB, WS_WUP = 19 * MiB, WS_WDN = 27 * MiB;
constexpr size_t WS_GLR = 36 * MiB;
constexpr size_t WS_MN = 38 * MiB, WS_KX = 46 * MiB, WS_VX = 54 * MiB;
constexpr size_t WS_HA = 64 * MiB;
constexpr size_t WS_MIX = 128 * MiB;
constexpr size_t WS_QA = 192 * MiB, WS_KA = 224 * MiB, WS_VA = 256 * MiB, WS_QG = 288 * MiB, WS_KG = 304 * MiB, WS_VG = 320 * MiB, WS_RG = 352 * MiB;
constexpr size_t WS_QX = 192 * MiB, WS_OX = 256 * MiB;
constexpr size_t WS_U = 192 * MiB;
constexpr size_t WS_END = 448 * MiB;
constexpr int CW_BAR = 1024;

constexpr int RING_OFF = 0, RING_BYTES = 131072;
constexpr int LDSCTL_OFF = RING_BYTES, MISC_OFF = LDSCTL_OFF + 320;
constexpr int LDS_BYTES = 147456;
#define GAS __attribute__((address_space(1)))
#define LAS __attribute__((address_space(3)))
typedef unsigned short bf16;
typedef unsigned v4u __attribute__((ext_vector_type(4)));
typedef float f32x4 __attribute__((ext_vector_type(4)));
typedef short bf16x8 __attribute__((ext_vector_type(8)));
typedef GAS unsigned gu32;
typedef GAS unsigned long long gu64;
#define RLX_AGENT __ATOMIC_RELAXED, __HIP_MEMORY_SCOPE_AGENT
#define LDS_WAIT() asm volatile("s_waitcnt lgkmcnt(0)" ::: "memory")
#define VM_WAIT() asm volatile("s_waitcnt vmcnt(0)" ::: "memory")
__device__ __forceinline__ unsigned long long rt() { return __builtin_amdgcn_s_memrealtime(); }
__device__ __forceinline__ unsigned f2bf(float f) { unsigned u = __builtin_bit_cast(unsigned, f); return (u + 0x7fffu + ((u >> 16) & 1u)) >> 16; }
__device__ __forceinline__ unsigned pk2(float lo, float hi) { return f2bf(lo) | (f2bf(hi) << 16); }
#define XB_TMO      128
#define XB_XCNT(j)  (256  + 64 * (j))
#define XB_XSUB(j)  (1280 + 64 * (j))
#define XB_XGEN(j)  (2304 + 64 * (j))
#define XB_TOP      3328
#define XB_TOPGEN   3392
#define XCD_BAR_WORDS 3456
#define XB_SPIN_CAP (1u << 18)

__device__ __forceinline__ unsigned xb_ld(unsigned* p)              { return __hip_atomic_load(p, __ATOMIC_RELAXED, __HIP_MEMORY_SCOPE_AGENT); }
__device__ __forceinline__ unsigned xb_add(unsigned* p, unsigned v) { return __hip_atomic_fetch_add(p, v, __ATOMIC_RELAXED, __HIP_MEMORY_SCOPE_AGENT); }
__device__ __forceinline__ unsigned xb_xcc_id() { return (unsigned)__builtin_amdgcn_s_getreg((3 << 11) | 20) & 0xFu; }
#define XB_SPIN(cond, bar) do { unsigned _sp = 0; while (cond) { __builtin_amdgcn_s_sleep(1); \
    if ((++_sp & 255u) == 0u) { if (xb_ld(&(bar)[XB_TMO])) break; if (_sp > XB_SPIN_CAP) { atomicAdd(&(bar)[XB_TMO], 1u); break; } } } } while (0)

struct XcdBarrier {
    unsigned* bar; unsigned x;
    volatile LAS unsigned* st;
};

__device__ __forceinline__ XcdBarrier xcd_barrier_post(unsigned* bar, volatile LAS unsigned* st) {
    XcdBarrier b; b.bar = bar; b.x = xb_xcc_id(); b.st = st;
    if (threadIdx.x == 0) (void)xb_add(&bar[XB_XCNT(b.x)], 1u);
    return b;
}
__device__ __forceinline__ void xcd_barrier_complete(unsigned* bar, unsigned x, unsigned& nloc, unsigned& nx) {
    const unsigned G = gridDim.x * gridDim.y * gridDim.z;
    unsigned sum, cnt, mine, sp = 0u;
    for (;;) {
        sum = 0u; cnt = 0u; mine = 0u;
#pragma unroll
        for (unsigned j = 0; j < 16; ++j) { const unsigned c = xb_ld(&bar[XB_XCNT(j)]); sum += c; cnt += (c > 0u) ? 1u : 0u; mine = (j == x) ? c : mine; }
        if (sum == G) break;
        __builtin_amdgcn_s_sleep(1);
        if ((++sp & 255u) == 0u) { if (xb_ld(&bar[XB_TMO])) break; if (sp > XB_SPIN_CAP) { atomicAdd(&bar[XB_TMO], 1u); break; } }
    }
    nloc = mine > 0u ? mine : 1u; nx = cnt > 0u ? cnt : 1u;
}

__device__ __forceinline__ void xcd_barrier(const XcdBarrier& b) {
    asm volatile("s_waitcnt vmcnt(0)" ::: "memory");
    __syncthreads();
    if (threadIdx.x == 0) {
        unsigned* bar = b.bar;
        __builtin_amdgcn_s_waitcnt(0);
        unsigned nloc = b.st[0], nx = b.st[1];
        if (nloc == 0u) { xcd_barrier_complete(bar, b.x, nloc, nx); b.st[0] = nloc; b.st[1] = nx; }
        const unsigned old = xb_add(&bar[XB_XSUB(b.x)], 1u);
        const unsigned gen = old / nloc;
        if (old + 1u == (gen + 1u) * nloc) {
            __builtin_amdgcn_fence(__ATOMIC_RELEASE, "agent");
            asm volatile("s_waitcnt vmcnt(0)" ::: "memory");
            const unsigned og = xb_add(&bar[XB_TOP], 1u);
            const unsigned tg = og / nx;
            if (og + 1u == (tg + 1u) * nx) xb_add(&bar[XB_TOPGEN], 1u);
            else XB_SPIN(xb_ld(&bar[XB_TOPGEN]) == tg, bar);
            __builtin_amdgcn_fence(__ATOMIC_ACQUIRE, "agent");
            xb_add(&bar[XB_XGEN(b.x)], 1u);
            asm volatile("s_waitcnt vmcnt(0)" ::: "memory");
        } else {
            XB_SPIN(xb_ld(&bar[XB_XGEN(b.x)]) == gen, bar);
            __builtin_amdgcn_fence(__ATOMIC_ACQUIRE, "agent");
            asm volatile("s_waitcnt vmcnt(0)" ::: "memory");
        }
    }
    __syncthreads();
}
struct Ctx {
    unsigned char* lds;
    LAS unsigned char* ldsl;
    int tid, lane, wave, gw, ngw, G, bid;
    const float *x, *mem, *rp, *norm_mix, *w_in, *w_gate_up, *b_gate, *g_norm, *w_out, *norm_xattn, *norm_mem, *w_xq, *w_xkv, *w_xo, *norm_mlp, *w_up, *w_down, *norm_final;
    float* out; unsigned char* ws;
};
__device__ __forceinline__ float wave_sum(float v) {
#pragma unroll
    for (int o = 1; o < 64; o <<= 1) v += __shfl_xor(v, o);
    return v;
}
__device__ __forceinline__ float wave_max(float v) {
#pragma unroll
    for (int o = 1; o < 64; o <<= 1) v = fmaxf(v, __shfl_xor(v, o));
    return v;
}
__device__ __forceinline__ float bf2f(bf16 b) { return __builtin_bit_cast(float, (unsigned)b << 16); }
__device__ __forceinline__ float bflo(unsigned w) { return __builtin_bit_cast(float, w << 16); }
__device__ __forceinline__ float bfhi(unsigned w) { return __builtin_bit_cast(float, w & 0xffff0000u); }

__host__ __device__ __forceinline__ int rel_bucket(int d) {
    if (d < 16) return d;
    int b = 16;
    b += (d >= 19); b += (d >= 21); b += (d >= 24); b += (d >= 27); b += (d >= 31); b += (d >= 35); b += (d >= 40); b += (d >= 46);
    b += (d >= 52); b += (d >= 59); b += (d >= 67); b += (d >= 77); b += (d >= 87); b += (d >= 99); b += (d >= 113);
    return b;
}

__host__ __device__ __forceinline__ int win_row(int n) { return n < 2560 ? n : (n < 2576 ? 3072 + (n - 2560) : n - 16); }
template <bool MAPWIN>
__device__ __forceinline__ void p0_transpose_item(const float* W, int K, int N, bf16* WT, LAS float* scr, int item, int lane) {
    const int nblk = (N + 31) / 32, kb = item / nblk, nb = item % nblk, k0 = 64 * kb, n0 = 32 * nb;
    const int col = n0 + (lane & 31);
#pragma unroll 8
    for (int i = 0; i < 32; ++i) { const int kk = 2 * i + (lane >> 5); scr[kk * 33 + (lane & 31)] = col < N ? W[(size_t)(k0 + kk) * N + col] : 0.f; }
    LDS_WAIT(); asm volatile("" ::: "memory");
    const int c = lane & 7;
#pragma unroll
    for (int j = 0; j < 4; ++j) { const int n = (lane >> 3) + 8 * j; const LAS float* s = scr + (8 * c) * 33 + n;
        v4u o; o.x = pk2(s[0 * 33], s[1 * 33]); o.y = pk2(s[2 * 33], s[3 * 33]); o.z = pk2(s[4 * 33], s[5 * 33]); o.w = pk2(s[6 * 33], s[7 * 33]);
        if (n0 + n < N) { const int r = MAPWIN ? win_row(n0 + n) : (n0 + n); *(GAS v4u*)(WT + (size_t)r * K + k0 + 8 * c) = o; } }
    LDS_WAIT(); asm volatile("" ::: "memory");
}
__device__ __forceinline__ void rms_row_to_bf16(const float* xrow, const float* gain, bf16* orow, int lane) {
    const GAS f32x4* xr = (const GAS f32x4*)xrow + lane; const GAS f32x4* gr = (const GAS f32x4*)gain + lane;
    f32x4 v[4]; float s = 0.f;
#pragma unroll
    for (int j = 0; j < 4; ++j) { v[j] = xr[64 * j]; s += (v[j].x * v[j].x + v[j].y * v[j].y) + (v[j].z * v[j].z + v[j].w * v[j].w); }
    const float rstd = 1.f / sqrtf(wave_sum(s) * (1.f / 1024.f) + EPS);
    GAS unsigned long long* o8 = (GAS unsigned long long*)orow + lane;
#pragma unroll
    for (int j = 0; j < 4; ++j) { const f32x4 g = gr[64 * j];
        o8[64 * j] = (unsigned long long)pk2(v[j].x * rstd * g.x, v[j].y * rstd * g.y) | ((unsigned long long)pk2(v[j].z * rstd * g.z, v[j].w * rstd * g.w) << 32); }
}
__device__ __forceinline__ void p0_prologue(const Ctx& F) {
    LAS float* scr = (LAS float*)(F.ldsl + RING_OFF + F.wave * 16384);
    unsigned char* ws = F.ws;
    constexpr int I_IN = 16 * 97, I_SQ = 16 * 32, I_KV = 16 * 64, I_UP = 16 * 128, I_DN = 64 * 32;
    constexpr int NITEMS = I_IN + 3 * I_SQ + I_KV + I_UP + I_DN;
    for (int it = F.gw; it < NITEMS; it += F.ngw) {
        int r = it;
        if (r < I_IN) { p0_transpose_item<true>(F.w_in, 1024, 3088, (bf16*)(ws + WS_WIN), scr, r, F.lane); continue; } r -= I_IN;
        if (r < I_SQ) { p0_transpose_item<false>(F.w_out, 1024, 1024, (bf16*)(ws + WS_WOUT), scr, r, F.lane); continue; } r -= I_SQ;
        if (r < I_SQ) { p0_transpose_item<false>(F.w_xq, 1024, 1024, (bf16*)(ws + WS_WXQ), scr, r, F.lane); continue; } r -= I_SQ;
        if (r < I_KV) { p0_transpose_item<false>(F.w_xkv, 1024, 2048, (bf16*)(ws + WS_WXKV), scr, r, F.lane); continue; } r -= I_KV;
        if (r < I_SQ) { p0_transpose_item<false>(F.w_xo, 1024, 1024, (bf16*)(ws + WS_WXO), scr, r, F.lane); continue; } r -= I_SQ;
        if (r < I_UP) { p0_transpose_item<false>(F.w_up, 1024, 4096, (bf16*)(ws + WS_WUP), scr, r, F.lane); continue; } r -= I_UP;
        p0_transpose_item<false>(F.w_down, 4096, 1024, (bf16*)(ws + WS_WDN), scr, r, F.lane);
    }
    const int gt = F.bid * (NWAVES * 64) + F.tid, ngt = F.G * NWAVES * 64;
    {
        GAS v4u* z = (GAS v4u*)(ws + WS_WIN + (size_t)3088 * 2048);
        for (int i = gt; i < 240 * 128; i += ngt) z[i] = (v4u){0u, 0u, 0u, 0u};
    }
    {
        GAS v4u* z = (GAS v4u*)(ws + WS_SSQ1);
        for (int i = gt; i < (3 * 128 * 1024 + 256 * 1024) / 16; i += ngt) z[i] = (v4u){0u, 0u, 0u, 0u};
    }
    if (F.bid == 0) {
        float* bt = (float*)(ws + WS_BIAS);
        for (int i = F.tid; i < 8 * 128; i += NWAVES * 64) { const int h = i >> 7, d = i & 127; bt[i] = F.rp[rel_bucket(d) * 8 + h] * LOG2E; }
    }
    for (int m = F.gw; m < M; m += F.ngw) rms_row_to_bf16(F.x + (size_t)m * DM, F.norm_mix, (bf16*)(ws + WS_HA) + (size_t)m * DM, F.lane);
    for (int m = F.gw; m < MM; m += F.ngw) rms_row_to_bf16(F.mem + (size_t)m * DM, F.norm_mem, (bf16*)(ws + WS_MN) + (size_t)m * DM, F.lane);
}

__device__ __forceinline__ void moba_naive(const Ctx& F) {
    float* sc = (float*)(F.lds + F.wave * 4096);
    const bf16* QA = (const bf16*)(F.ws + WS_QA); const bf16* KA = (const bf16*)(F.ws + WS_KA); const bf16* VA = (const bf16*)(F.ws + WS_VA);
    const float* ksum = (const float*)(F.ws + WS_KSUM); const float* bias = (const float*)(F.ws + WS_BIAS);
    bf16* MIX = (bf16*)(F.ws + WS_MIX);
    const int lane = F.lane;
    for (int task = F.gw; task < M * AH; task += F.ngw) {
        const int h = task / M, row = task % M;
        const int b = row >> 11, t = row & 2047, qb = t >> 8;
        const bf16* qrow = QA + (size_t)row * AW + h * AHD;
        float q[64];
#pragma unroll
        for (int c = 0; c < 8; ++c) { const v4u w = *(const v4u*)(qrow + 8 * c);
            q[8 * c + 0] = bflo(w.x); q[8 * c + 1] = bfhi(w.x); q[8 * c + 2] = bflo(w.y); q[8 * c + 3] = bfhi(w.y);
            q[8 * c + 4] = bflo(w.z); q[8 * c + 5] = bfhi(w.z); q[8 * c + 6] = bflo(w.w); q[8 * c + 7] = bfhi(w.w); }
        const float qd = bf2f(qrow[lane]);
        float gate[8];
#pragma unroll
        for (int j = 0; j < 8; ++j) { const float g = wave_sum(qd * ksum[(size_t)(b * 8 + j) * 512 + h * 64 + lane]); gate[j] = (j < qb) ? g : -INFINITY; }
        unsigned sel = 0u;
#pragma unroll
        for (int r = 0; r < 3; ++r) { int best = -1; float bv = -INFINITY;
#pragma unroll
            for (int j = 0; j < 8; ++j) { const bool ok = !((sel >> j) & 1u) && (j < qb) && (gate[j] > bv); if (ok) { bv = gate[j]; best = j; } }
            if (best >= 0) sel |= 1u << best; }
        sel |= 1u << qb;
        sel = (unsigned)__builtin_amdgcn_readfirstlane((int)sel);
        int nb = 0; float mx = -INFINITY;
        for (int j = 0; j <= qb; ++j) {
            if (!((sel >> j) & 1u)) continue;
            for (int kk = 0; kk < 4; ++kk) {
                const int kpos = j * 256 + kk * 64 + lane; const int d = t - kpos;
                const bf16* krow = KA + (size_t)(b * SEQ + kpos) * AW + h * AHD;
                float s = 0.f;
#pragma unroll
                for (int c = 0; c < 8; ++c) { const v4u w = *(const v4u*)(krow + 8 * c);
                    s += q[8 * c + 0] * bflo(w.x) + q[8 * c + 1] * bfhi(w.x) + q[8 * c + 2] * bflo(w.y) + q[8 * c + 3] * bfhi(w.y)
                       + q[8 * c + 4] * bflo(w.z) + q[8 * c + 5] * bfhi(w.z) + q[8 * c + 6] * bflo(w.w) + q[8 * c + 7] * bfhi(w.w); }
                if (d >= 0) s += bias[h * 128 + (d < 127 ? d : 127)]; else s = -INFINITY;
                sc[nb * 256 + kk * 64 + lane] = s; mx = fmaxf(mx, s);
            }
            ++nb;
        }
        mx = wave_max(mx);
        float sum = 0.f;
        for (int i = lane; i < nb * 256; i += 64) { const float p = exp2f(sc[i] - mx); sc[i] = p; sum += p; }
        sum = wave_sum(sum);
        asm volatile("s_waitcnt lgkmcnt(0)" ::: "memory");
        float o = 0.f; int ib = 0;
        for (int j = 0; j <= qb; ++j) {
            if (!((sel >> j) & 1u)) continue;
            const bf16* vcol = VA + (size_t)(b * SEQ + j * 256) * AW + h * AHD + lane;
#pragma unroll 8
            for (int k = 0; k < 256; ++k) o += sc[ib * 256 + k] * bf2f(vcol[(size_t)k * AW]);
            ++ib;
        }
        MIX[(size_t)row * DM + h * AHD + lane] = (bf16)f2bf(o / sum);
        asm volatile("s_waitcnt lgkmcnt(0)" ::: "memory");
    }
}

__device__ __forceinline__ float log_sigmoid(float z) { return z < 0.f ? z - log1pf(expf(z)) : -log1pf(expf(-z)); }
__device__ __forceinline__ void gla_naive(const Ctx& F) {
    constexpr int TB = 16;
    float* qs = (float*)F.lds;
    float* ks = qs + TB * 64;
    float* as_ = ks + TB * 64;
    float* vs = as_ + TB * 64;
    float* gl = vs + TB * 128;
    float* part = gl + TB * 16;
    float* ob = part + 2 * 4 * 128;
    const bf16* QG = (const bf16*)(F.ws + WS_QG); const bf16* KG = (const bf16*)(F.ws + WS_KG); const bf16* VG = (const bf16*)(F.ws + WS_VG); const bf16* RG = (const bf16*)(F.ws + WS_RG);
    const float* GLR = (const float*)(F.ws + WS_GLR); bf16* MIX = (bf16*)(F.ws + WS_MIX);
    const int tid = F.tid, dv = tid & 127, g4 = tid >> 7;
    for (int chain = F.bid; chain < BATCH * GH; chain += F.G) {
        const int b = chain >> 2, hg = chain & 3;
        float S[16];
#pragma unroll
        for (int i = 0; i < 16; ++i) S[i] = 0.f;
        for (int t0 = 0; t0 < SEQ; t0 += TB) {
            const size_t r0 = (size_t)b * SEQ + t0;
            __syncthreads();
            for (int i = tid; i < TB * 64; i += 512) { const int tt = i >> 6, d = i & 63; qs[i] = bf2f(QG[(r0 + tt) * GKW + hg * 64 + d]); ks[i] = bf2f(KG[(r0 + tt) * GKW + hg * 64 + d]); }
            for (int i = tid; i < TB * 128; i += 512) { const int tt = i >> 7, d = i & 127; vs[i] = bf2f(VG[(r0 + tt) * GW + hg * 128 + d]); }
            if (tid < TB * 16) gl[tid] = GLR[(r0 + (tid >> 4)) * 16 + (tid & 15)];
            __syncthreads();
            for (int i = tid; i < TB * 64; i += 512) { const int tt = i >> 6, d = i & 63; float z = F.b_gate[hg * 64 + d];
#pragma unroll
                for (int r = 0; r < 16; ++r) z += gl[tt * 16 + r] * F.w_gate_up[r * GKW + hg * 64 + d];
                as_[i] = expf(log_sigmoid(z) * (1.0f / 16.0f)); }
            __syncthreads();
            for (int tt = 0; tt < TB; ++tt) {
                float po = 0.f; const float vv = vs[tt * 128 + dv];
#pragma unroll
                for (int i = 0; i < 16; ++i) { const int dk = 16 * g4 + i; S[i] = as_[tt * 64 + dk] * S[i] + ks[tt * 64 + dk] * vv; po += qs[tt * 64 + dk] * S[i]; }
                part[((tt & 1) * 4 + g4) * 128 + dv] = po;
                __syncthreads();
                if (tid < 128) ob[tt * 128 + tid] = (part[((tt & 1) * 4 + 0) * 128 + tid] + part[((tt & 1) * 4 + 1) * 128 + tid]) + (part[((tt & 1) * 4 + 2) * 128 + tid] + part[((tt & 1) * 4 + 3) * 128 + tid]);
            }
            __syncthreads();
#pragma unroll
            for (int k = 0; k < 2; ++k) { const int tt = 2 * F.wave + k; const size_t row = r0 + tt;
                const float o0 = ob[tt * 128 + F.lane], o1 = ob[tt * 128 + 64 + F.lane];
                const float rstd = 1.f / sqrtf(wave_sum(o0 * o0 + o1 * o1) * (1.f / 128.f) + EPS);
                const float r0v = bf2f(RG[row * GW + hg * 128 + F.lane]), r1v = bf2f(RG[row * GW + hg * 128 + 64 + F.lane]);
                const float y0 = o0 * rstd * F.g_norm[F.lane] * (r0v / (1.f + expf(-r0v))), y1 = o1 * rstd * F.g_norm[64 + F.lane] * (r1v / (1.f + expf(-r1v)));
                MIX[row * DM + AW + hg * 128 + F.lane] = (bf16)f2bf(y0); MIX[row * DM + AW + hg * 128 + 64 + F.lane] = (bf16)f2bf(y1); }
        }
        __syncthreads();
    }
}

__device__ __forceinline__ void xattn_naive(const Ctx& F) {
    float* qs = (float*)(F.lds + F.wave * 2048);
    float* sc = qs + 256;
    const bf16* QX = (const bf16*)(F.ws + WS_QX); const bf16* KX = (const bf16*)(F.ws + WS_KX); const bf16* VX = (const bf16*)(F.ws + WS_VX); bf16* OX = (bf16*)(F.ws + WS_OX);
    const int lane = F.lane;
    for (int task = F.gw; task < M * XH; task += F.ngw) {
        const int h = task / M, row = task % M, b = row >> 11;
        {   const unsigned long long w = *(const unsigned long long*)(QX + (size_t)row * DM + h * XHD + 4 * lane);
            qs[4 * lane + 0] = bflo((unsigned)w); qs[4 * lane + 1] = bfhi((unsigned)w); qs[4 * lane + 2] = bflo((unsigned)(w >> 32)); qs[4 * lane + 3] = bfhi((unsigned)(w >> 32)); }
        asm volatile("s_waitcnt lgkmcnt(0)" ::: "memory");
        float mx = -INFINITY;
        for (int kk = 0; kk < 4; ++kk) {
            const bf16* krow = KX + (size_t)(b * MEMLEN + kk * 64 + lane) * DM + h * XHD;
            float s = 0.f;
#pragma unroll 4
            for (int c = 0; c < 32; ++c) { const v4u w = *(const v4u*)(krow + 8 * c); const float* qq = qs + 8 * c;
                s += qq[0] * bflo(w.x) + qq[1] * bfhi(w.x) + qq[2] * bflo(w.y) + qq[3] * bfhi(w.y) + qq[4] * bflo(w.z) + qq[5] * bfhi(w.z) + qq[6] * bflo(w.w) + qq[7] * bfhi(w.w); }
            sc[kk * 64 + lane] = s; mx = fmaxf(mx, s);
        }
        mx = wave_max(mx);
        float sum = 0.f;
        for (int kk = 0; kk < 4; ++kk) { const float p = exp2f(sc[kk * 64 + lane] - mx); sc[kk * 64 + lane] = p; sum += p; }
        sum = wave_sum(sum);
        asm volatile("s_waitcnt lgkmcnt(0)" ::: "memory");
        float o0 = 0.f, o1 = 0.f, o2 = 0.f, o3 = 0.f;
        const bf16* vcol = VX + (size_t)(b * MEMLEN) * DM + h * XHD + 4 * lane;
#pragma unroll 8
        for (int k = 0; k < 256; ++k) { const unsigned long long w = *(const unsigned long long*)(vcol + (size_t)k * DM); const float p = sc[k];
            o0 += p * bflo((unsigned)w); o1 += p * bfhi((unsigned)w); o2 += p * bflo((unsigned)(w >> 32)); o3 += p * bfhi((unsigned)(w >> 32)); }
        const float inv = 1.f / sum;
        *(unsigned long long*)(OX + (size_t)row * DM + h * XHD + 4 * lane) = (unsigned long long)pk2(o0 * inv, o1 * inv) | ((unsigned long long)pk2(o2 * inv, o3 * inv) << 32);
        asm volatile("s_waitcnt lgkmcnt(0)" ::: "memory");
    }
}

__device__ __forceinline__ void final_norm(const Ctx& F) {
    const float* ssq = (const float*)(F.ws + WS_SSQ3);
    for (int m = F.gw; m < M; m += F.ngw) {
        GAS f32x4* xr = (GAS f32x4*)(F.out + (size_t)m * DM) + F.lane; const GAS f32x4* gr = (const GAS f32x4*)F.norm_final + F.lane;
        const float rstd = 1.f / sqrtf(ssq[m] * (1.f / 1024.f) + EPS);
#pragma unroll
        for (int j = 0; j < 4; ++j) { const f32x4 v = xr[64 * j], g = gr[64 * j]; xr[64 * j] = (f32x4){v.x * rstd * g.x, v.y * rstd * g.y, v.z * rstd * g.z, v.w * rstd * g.w}; }
    }
}

constexpr int NPHASE = 10;
struct Args { const float* in[18]; float* out; unsigned char* ws; int ph_lo, ph_hi, li, pad; };
__global__ void __launch_bounds__(NWAVES * 64, 2) mk_fwd(Args args) {
    extern __shared__ __attribute__((aligned(16))) unsigned char lds[];
    Ctx F;
    F.lds = lds; F.ldsl = (LAS unsigned char*)lds;
    F.tid = threadIdx.x; F.lane = F.tid & 63; F.wave = __builtin_amdgcn_readfirstlane(F.tid >> 6);
    F.G = gridDim.x; F.bid = blockIdx.x; F.gw = F.bid * NWAVES + F.wave; F.ngw = F.G * NWAVES;
    F.x = args.in[0]; F.mem = args.in[1]; F.rp = args.in[2]; F.norm_mix = args.in[3]; F.w_in = args.in[4]; F.w_gate_up = args.in[5]; F.b_gate = args.in[6]; F.g_norm = args.in[7];
    F.w_out = args.in[8]; F.norm_xattn = args.in[9]; F.norm_mem = args.in[10]; F.w_xq = args.in[11]; F.w_xkv = args.in[12]; F.w_xo = args.in[13]; F.norm_mlp = args.in[14];
    F.w_up = args.in[15]; F.w_down = args.in[16]; F.norm_final = args.in[17];
    F.out = args.out; F.ws = args.ws;
    unsigned char* ws = args.ws;
    volatile LAS unsigned* MISC = (volatile LAS unsigned*)(F.ldsl + MISC_OFF);
    for (int u = F.tid; u < (LDS_BYTES - LDSCTL_OFF) / 4; u += NWAVES * 64) ((LAS unsigned*)(F.ldsl + LDSCTL_OFF))[u] = 0u;
    __syncthreads();
    const int lo = args.ph_lo, hi = args.ph_hi;
    XcdBarrier bar; bar.bar = (unsigned*)(ws + WS_CTL) + CW_BAR + args.li * XCD_BAR_WORDS; bar.x = 0; bar.st = nullptr;
    if (hi - lo > 1) bar = xcd_barrier_post((unsigned*)(ws + WS_CTL) + CW_BAR + args.li * XCD_BAR_WORDS, MISC + 8);
#define IN(k) (lo <= (k) && (k) < hi)
#define SEAM(k) do { if (IN(k) && IN((k) + 1)) xcd_barrier(bar); } while (0)
    float* ssq1 = (float*)(ws + WS_SSQ1); float* ssq2 = (float*)(ws + WS_SSQ2); float* ssq3 = (float*)(ws + WS_SSQ3);
    bf16* HA = (bf16*)(ws + WS_HA);

    if (IN(0)) { p0_prologue(F); SEAM(0); }

    if (IN(1)) {
        {   pg8::Gemm g{HA, (const bf16*)(ws + WS_WIN), M, NIN, DM}; pg8::StaticOrder S; S.init(M, NIN, F.G, F.bid);
            pg8::EpiInProj E{(bf16*)(ws + WS_QA), (bf16*)(ws + WS_KA), (bf16*)(ws + WS_VA), (bf16*)(ws + WS_QG), (bf16*)(ws + WS_KG), (bf16*)(ws + WS_VG), (bf16*)(ws + WS_RG),
                             (float*)(ws + WS_GLR), (float*)(ws + WS_KSUM), C2A, 0.125f};
            pg8::gemm_phase<pg8::EpiInProj, pg8::StaticOrder, PG8_ALIGN, PG8_SP2>(F.ldsl + RING_OFF, g, S, E); }
        {   pg8::Gemm g{(const bf16*)(ws + WS_MN), (const bf16*)(ws + WS_WXKV), MM, 2048, DM}; pg8::StaticOrder S; S.init(MM, 2048, F.G, F.bid);
            pg8::EpiSplitBf16 E{(bf16*)(ws + WS_KX), (bf16*)(ws + WS_VX), 4, DM};
            pg8::gemm_phase<pg8::EpiSplitBf16, pg8::StaticOrder, PG8_ALIGN, PG8_SP2>(F.ldsl + RING_OFF, g, S, E); }
        SEAM(1);
    }
    if (IN(2)) { gla_naive(F); moba_naive(F); SEAM(2); }
    if (IN(3)) {
        pg8::Gemm g{(const bf16*)(ws + WS_MIX), (const bf16*)(ws + WS_WOUT), M, DM, DM}; pg8::StaticOrder S; S.init(M, DM, F.G, F.bid);
        pg8::EpiResidual<true> E{F.x, F.out, HA, F.norm_xattn, ssq1};
        pg8::gemm_phase<pg8::EpiResidual<true>, pg8::StaticOrder, PG8_ALIGN, PG8_SP2>(F.ldsl + RING_OFF, g, S, E);
        SEAM(3);
    }
    if (IN(4)) {
        pg8::Gemm g{HA, (const bf16*)(ws + WS_WXQ), M, DM, DM}; pg8::StaticOrder S; S.init(M, DM, F.G, F.bid);
        pg8::EpiRowScale<0> E{(bf16*)(ws + WS_QX), DM, ssq1, EPS, C2X};
        pg8::gemm_phase<pg8::EpiRowScale<0>, pg8::StaticOrder, PG8_ALIGN, PG8_SP2>(F.ldsl + RING_OFF, g, S, E);
        SEAM(4);
    }
    if (IN(5)) { xattn_naive(F); SEAM(5); }
    if (IN(6)) {
        pg8::Gemm g{(const bf16*)(ws + WS_OX), (const bf16*)(ws + WS_WXO), M, DM, DM}; pg8::StaticOrder S; S.init(M, DM, F.G, F.bid);
        pg8::EpiResidual<true> E{F.out, F.out, HA, F.norm_mlp, ssq2};
        pg8::gemm_phase<pg8::EpiResidual<true>, pg8::StaticOrder, PG8_ALIGN, PG8_SP2>(F.ldsl + RING_OFF, g, S, E);
        SEAM(6);
    }
    if (IN(7)) {
        pg8::Gemm g{HA, (const bf16*)(ws + WS_WUP), M, FF, DM}; pg8::StaticOrder S; S.init(M, FF, F.G, F.bid);
        pg8::EpiRowScale<1> E{(bf16*)(ws + WS_U), FF, ssq2, EPS, 1.0f};
        pg8::gemm_phase<pg8::EpiRowScale<1>, pg8::StaticOrder, PG8_ALIGN, PG8_SP2>(F.ldsl + RING_OFF, g, S, E);
        SEAM(7);
    }
    if (IN(8)) {
        pg8::Gemm g{(const bf16*)(ws + WS_U), (const bf16*)(ws + WS_WDN), M, DM, FF}; pg8::StaticOrder S; S.init(M, DM, F.G, F.bid);
        pg8::EpiResidual<false> E{F.out, F.out, nullptr, nullptr, ssq3};
        pg8::gemm_phase<pg8::EpiResidual<false>, pg8::StaticOrder, PG8_ALIGN, PG8_SP2>(F.ldsl + RING_OFF, g, S, E);
        SEAM(8);
    }
    if (IN(9)) { final_norm(F); }
#undef IN
#undef SEAM
}

#ifndef MK_CUTS
#define MK_CUTS 0x1FF
#endif
extern "C" void kernel_launch(void* const* d_in, const int* in_sizes, int n_in, void* d_out, int out_size, void* d_ws, size_t ws_size, hipStream_t stream) {
    static int grid = 0;
    if (grid == 0) {
        if (n_in != 18 || out_size != M * DM || ws_size < WS_END) { fprintf(stderr, "kernel_launch: unexpected shapes (n_in %d out %d ws %zu)\n", n_in, out_size, ws_size); grid = -1; return; }
        int dev = 0, cus = 0;
        if (hipGetDevice(&dev) != hipSuccess || hipDeviceGetAttribute(&cus, hipDeviceAttributeMultiprocessorCount, dev) != hipSuccess) { grid = -1; return; }
        if (hipFuncSetAttribute((const void*)mk_fwd, hipFuncAttributeMaxDynamicSharedMemorySize, LDS_BYTES) != hipSuccess) { fprintf(stderr, "kernel_launch: hipFuncSetAttribute failed\n"); grid = -1; return; }
        (void)hipGetLastError();
        grid = cus;
    }
    if (grid < 0) return;
    (void)hipMemsetAsync((char*)d_ws + WS_CTL, 0, CTL_ZERO_BYTES, stream);
    Args a{};
    for (int i = 0; i < 18; ++i) a.in[i] = (const float*)d_in[i];
    a.out = (float*)d_out; a.ws = (unsigned char*)d_ws;
    int lo = 0, li = 0;
    for (int k = 0; k < NPHASE; ++k) {
        if (k == NPHASE - 1 || ((MK_CUTS >> k) & 1)) {
            a.ph_lo = lo; a.ph_hi = k + 1; a.li = li++;
            hipLaunchKernelGGL(mk_fwd, dim3(grid), dim3(NWAVES * 64), LDS_BYTES, stream, a);
            lo = k + 1;
        }
    }
}
```

```cpp
#include <hip/hip_runtime.h>
#include <cstdio>
#include <cstdint>
#include <cmath>
namespace pg8 {
#define PG8_LAS __attribute__((address_space(3)))
typedef unsigned short bf16_t;
typedef short bf16x8 __attribute__((ext_vector_type(8)));
typedef float f32x4 __attribute__((ext_vector_type(4)));
typedef unsigned u32x4 __attribute__((ext_vector_type(4)));
constexpr int BM = 256, BK = 64, HALF = 128, HTB = HALF * BK * 2  , STAGE_BYTES = 8 * HTB, NXCD = 8, WGM = 8;

__host__ __device__ __forceinline__ int lds_byte(int r, int c) { const int st = (r >> 4) * 2 + (c >> 5), rr = r & 15, cc = c & 31, ob = rr * 64 + cc * 2; return st * 1024 + (ob ^ (((ob >> 9) & 1) << 5)); }
__host__ __device__ __forceinline__ void stage_rc(int b, int& R, int& C) { const int st = b / 1024, sb = b % 1024, swz = sb ^ (((sb >> 9) & 1) << 5); R = (st >> 1) * 16 + swz / 64; C = (st & 1) * 32 + (swz % 64) / 2; }
__host__ __device__ __forceinline__ int perm32(int rho) { const int n = rho >> 4, i = rho & 15; return 8 * (i >> 2) + 4 * n + (i & 3); }

struct Unit { int pm, pn; };
struct Gemm { const bf16_t* A; const bf16_t* Bt; int M, N, K; };

struct StaticOrder {
    int nM, nN, nwg, G, c;
    __host__ __device__ void init(int M, int N, int G_, int c_) { nM = M / BM; nN = N / BM; nwg = nM * nN; G = G_; c = c_; }
    __host__ __device__ bool next(int i, Unit& u) const {
        const long L = (long)i * G + c; if (L >= nwg) return false;
        int wgid = (int)L; { const int q = nwg / NXCD, r = nwg % NXCD, xcd = wgid % NXCD, off = wgid / NXCD; wgid = (xcd < r ? xcd * (q + 1) : r * (q + 1) + (xcd - r) * q) + off; }
        const int nig = WGM * nN, gid = wgid / nig, fm = gid * WGM, gsz = (nM - fm) < WGM ? (nM - fm) : WGM;
        u.pm = fm + ((wgid % nig) % gsz); u.pn = (wgid % nig) / gsz; return true;
    }
    __device__ __forceinline__ void a_ready(const Unit&) const {}
    __device__ __forceinline__ void done(const Unit&) const {}
};
__device__ __forceinline__ unsigned cvt_pk_bf16(float lo, float hi) { unsigned r; asm volatile("v_cvt_pk_bf16_f32 %0, %1, %2" : "=v"(r) : "v"(lo), "v"(hi)); return r; }
typedef float f32x2 __attribute__((ext_vector_type(2)));
typedef unsigned u32x2e __attribute__((ext_vector_type(2)));
__device__ __forceinline__ u32x4 pack8(f32x4 v0, f32x4 v1) { u32x4 w; w.x = cvt_pk_bf16(v0[0], v0[1]); w.y = cvt_pk_bf16(v0[2], v0[3]); w.z = cvt_pk_bf16(v1[0], v1[1]); w.w = cvt_pk_bf16(v1[2], v1[3]); return w; }

struct EpiInProj {
    static constexpr bool PERM = true, AFTER_DRAIN = false;
    bf16_t *qa, *ka, *va, *qg, *kg, *vg, *rg; float* glr; float* ksum; float qa_scale, qg_scale;
    __device__ __forceinline__ void operator()(const f32x4 (&acc)[2][2][4][2], const Unit& u, int wr, int wc, int fr, int fq) const {
        const int pn = u.pn; const int row0 = u.pm * BM + wr * 64 + fr; const int cin = wc * 32 + 8 * fq;
        if (pn == 12) {
            if (wc == 0 && fq < 2) {
#pragma unroll
                for (int ai = 0; ai < 2; ++ai)
#pragma unroll
                    for (int m = 0; m < 4; ++m) { float* p = glr + (size_t)(row0 + ai * HALF + m * 16) * 16 + 8 * fq; *(f32x4*)p = acc[ai][0][m][0]; *(f32x4*)(p + 4) = acc[ai][0][m][1]; }
            }
            return;
        }
        bf16_t* base; int pitch, coff; float sc = 1.f;
        if (pn < 2) { base = qa; pitch = 512; coff = pn * 256; sc = qa_scale; }
        else if (pn < 4) { base = ka; pitch = 512; coff = (pn - 2) * 256; }
        else if (pn < 6) { base = va; pitch = 512; coff = (pn - 4) * 256; }
        else if (pn == 6) { base = qg; pitch = 256; coff = 0; sc = qg_scale; }
        else if (pn == 7) { base = kg; pitch = 256; coff = 0; }
        else if (pn < 10) { base = vg; pitch = 512; coff = (pn - 8) * 256; }
        else { base = rg; pitch = 512; coff = (pn - 10) * 256; }
#pragma unroll
        for (int ai = 0; ai < 2; ++ai)
#pragma unroll
            for (int m = 0; m < 4; ++m) { bf16_t* rowp = base + (size_t)(row0 + ai * HALF + m * 16) * pitch + coff + cin;
#pragma unroll
                for (int bj = 0; bj < 2; ++bj) *(u32x4*)(rowp + bj * HALF) = pack8(acc[ai][bj][m][0] * sc, acc[ai][bj][m][1] * sc); }
        if (pn == 2 || pn == 3) {
            float* kp = ksum + (size_t)u.pm * 512 + (pn - 2) * 256 + cin;
#pragma unroll
            for (int bj = 0; bj < 2; ++bj) {
                f32x4 s0 = {0.f, 0.f, 0.f, 0.f}, s1 = {0.f, 0.f, 0.f, 0.f};
#pragma unroll
                for (int ai = 0; ai < 2; ++ai)
#pragma unroll
                    for (int m = 0; m < 4; ++m) { s0 += acc[ai][bj][m][0]; s1 += acc[ai][bj][m][1]; }
#pragma unroll
                for (int e = 0; e < 4; ++e) {
#pragma unroll
                    for (int o = 1; o < 16; o <<= 1) { s0[e] += __shfl_xor(s0[e], o); s1[e] += __shfl_xor(s1[e], o); }
                }
                if (fr == 0) {
#pragma unroll
                    for (int e = 0; e < 4; ++e) { atomicAdd(kp + bj * HALF + e, s0[e]); atomicAdd(kp + bj * HALF + 4 + e, s1[e]); }
                }
            }
        }
    }
};

struct EpiSplitBf16 {
    static constexpr bool PERM = true, AFTER_DRAIN = false;
    bf16_t *o0, *o1; int split_tiles; int pitch;
    __device__ __forceinline__ void operator()(const f32x4 (&acc)[2][2][4][2], const Unit& u, int wr, int wc, int fr, int fq) const {
        const int row0 = u.pm * BM + wr * 64 + fr; const int t = u.pn >= split_tiles ? 1 : 0;
        bf16_t* base = t ? o1 : o0; const int col0 = (u.pn - t * split_tiles) * BM + wc * 32 + 8 * fq;
#pragma unroll
        for (int ai = 0; ai < 2; ++ai)
#pragma unroll
            for (int m = 0; m < 4; ++m) { bf16_t* rowp = base + (size_t)(row0 + ai * HALF + m * 16) * pitch + col0;
#pragma unroll
                for (int bj = 0; bj < 2; ++bj) *(u32x4*)(rowp + bj * HALF) = pack8(acc[ai][bj][m][0], acc[ai][bj][m][1]); }
    }
};

template <bool WITH_AN> struct EpiResidual {
    static constexpr bool PERM = true, AFTER_DRAIN = false;
    const float* xb; float* xo; bf16_t* an; const float* gain; float* ssq;
    __device__ __forceinline__ void operator()(const f32x4 (&acc)[2][2][4][2], const Unit& u, int wr, int wc, int fr, int fq) const {
        const int row0 = u.pm * BM + wr * 64 + fr; const int col0 = u.pn * BM + wc * 32 + 8 * fq;
        f32x4 g[2][2];
        if (WITH_AN) {
#pragma unroll
            for (int bj = 0; bj < 2; ++bj) { g[bj][0] = *(const f32x4*)(gain + col0 + bj * HALF); g[bj][1] = *(const f32x4*)(gain + col0 + bj * HALF + 4); }
        }
#pragma unroll
        for (int ai = 0; ai < 2; ++ai)
#pragma unroll
            for (int m = 0; m < 4; ++m) { const int row = row0 + ai * HALF + m * 16; const size_t off = (size_t)row * 1024 + col0; float sq = 0.f;
#pragma unroll
                for (int bj = 0; bj < 2; ++bj) {
                    const f32x4 b0 = *(const f32x4*)(xb + off + bj * HALF), b1 = *(const f32x4*)(xb + off + bj * HALF + 4);
                    const f32x4 v0 = b0 + acc[ai][bj][m][0], v1 = b1 + acc[ai][bj][m][1];
                    *(f32x4*)(xo + off + bj * HALF) = v0; *(f32x4*)(xo + off + bj * HALF + 4) = v1;
                    sq += (v0[0] * v0[0] + v0[1] * v0[1]) + (v0[2] * v0[2] + v0[3] * v0[3]) + (v1[0] * v1[0] + v1[1] * v1[1]) + (v1[2] * v1[2] + v1[3] * v1[3]);
                    if (WITH_AN) *(u32x4*)(an + off + bj * HALF) = pack8(v0 * g[bj][0], v1 * g[bj][1]);
                }
                sq += __shfl_xor(sq, 16); sq += __shfl_xor(sq, 32);
                if (fq == 0) atomicAdd(ssq + row, sq);
            }
    }
};

template <int ACT> struct EpiRowScale {
    static constexpr bool PERM = true, AFTER_DRAIN = false;
    bf16_t* out; int pitch; const float* ssq; float eps, scale;
    __device__ __forceinline__ void operator()(const f32x4 (&acc)[2][2][4][2], const Unit& u, int wr, int wc, int fr, int fq) const {
        const int row0 = u.pm * BM + wr * 64 + fr; const int col0 = u.pn * BM + wc * 32 + 8 * fq;
#pragma unroll
        for (int ai = 0; ai < 2; ++ai)
#pragma unroll
            for (int m = 0; m < 4; ++m) { const int row = row0 + ai * HALF + m * 16; const float rs = __builtin_amdgcn_rsqf(ssq[row] * (1.0f / 1024.0f) + eps) ;
                bf16_t* rowp = out + (size_t)row * pitch + col0;
#pragma unroll
                for (int bj = 0; bj < 2; ++bj) { f32x4 v0 = acc[ai][bj][m][0] * rs, v1 = acc[ai][bj][m][1] * rs;
                    if (ACT == 1) {
#pragma unroll
                        for (int e = 0; e < 4; ++e) { const float a = fmaxf(v0[e], 0.f), b = fmaxf(v1[e], 0.f); v0[e] = a * a; v1[e] = b * b; }
                    }
                    *(u32x4*)(rowp + bj * HALF) = pack8(v0 * scale, v1 * scale); }
            }
    }
};
template <class Epi, class Sched, bool ALIGN_EPI = false, bool SP2 = false>
__device__ __forceinline__ void gemm_phase(PG8_LAS unsigned char* lds, const Gemm g, const Sched& S, const Epi& E) {
    const int tid = threadIdx.x, wid = __builtin_amdgcn_readfirstlane(tid >> 6), lane = tid & 63, wr = wid >> 2, wc = wid & 3, fr = lane & 15, fq = lane >> 4;
    const int K = g.K, nt = K / BK;
    unsigned voffA[2], voffB[2];
#pragma unroll
    for (int i = 0; i < 2; ++i) { int R, C; stage_rc(tid * 16 + i * 8192, R, C); const int Rb = Epi::PERM ? ((R & ~31) + perm32(R & 31)) : R;
        voffA[i] = (unsigned)(R * K + C) * 2u; voffB[i] = (unsigned)(Rb * K + C) * 2u; }
    const size_t kstep = (size_t)(BK * 2);
    const size_t hstep = (size_t)HALF * K * 2;
    const size_t tstep = 2 * hstep;
    const unsigned ldsw = (unsigned)wid * 1024u;
    const int aoff = lds_byte(wr * 64 + fr, fq * 8), boff = lds_byte(wc * 32 + fr, fq * 8);
#define PG8_SA(b, h) (((b) * 2 + (h)) * HTB)
#define PG8_SB(b, h) ((4 + (b) * 2 + (h)) * HTB)
#define PG8_STAGE(bufoff, gbase, voff) do { _Pragma("unroll") for (int _i = 0; _i < 2; ++_i) \
        __builtin_amdgcn_global_load_lds((const unsigned*)((const char*)(gbase) + (voff)[_i]), (PG8_LAS unsigned*)(lds + (bufoff) + ldsw + _i * 8192), 16, 0, 0); } while (0)
#define PG8_LDA(dst, b, h) do { _Pragma("unroll") for (int m = 0; m < 4; ++m) _Pragma("unroll") for (int k = 0; k < 2; ++k) dst[m][k] = *(const PG8_LAS bf16x8*)(lds + PG8_SA(b, h) + aoff + m * 2048 + k * 1024); } while (0)
#define PG8_LDB(dst, b, h) do { _Pragma("unroll") for (int n = 0; n < 2; ++n) _Pragma("unroll") for (int k = 0; k < 2; ++k) dst[n][k] = *(const PG8_LAS bf16x8*)(lds + PG8_SB(b, h) + boff + n * 2048 + k * 1024); } while (0)
#define PG8_MMA(ai, bj, At, Bt) do { __builtin_amdgcn_s_setprio(1); _Pragma("unroll") for (int m = 0; m < 4; ++m) _Pragma("unroll") for (int n = 0; n < 2; ++n) _Pragma("unroll") for (int k = 0; k < 2; ++k) \
        acc[ai][bj][m][n] = __builtin_amdgcn_mfma_f32_16x16x32_bf16(Bt[n][k], At[m][k], acc[ai][bj][m][n], 0, 0, 0); __builtin_amdgcn_s_setprio(0); } while (0)
#define PG8_WAIT_V(n) asm volatile("s_waitcnt vmcnt(" #n ")" ::: "memory")
#define PG8_WAIT_L(n) asm volatile("s_waitcnt lgkmcnt(" #n ")" ::: "memory")
#define PG8_BAR __builtin_amdgcn_s_barrier()
#define PG8_SCHED __builtin_amdgcn_sched_barrier(0)
    Unit cur, nxt; int ui = 0;
    if (!S.next(0, cur)) return;
    f32x4 acc[2][2][4][2];
#pragma unroll
    for (int a = 0; a < 2; ++a)
#pragma unroll
        for (int b = 0; b < 2; ++b)
#pragma unroll
            for (int m = 0; m < 4; ++m)
#pragma unroll
                for (int n = 0; n < 2; ++n) acc[a][b][m][n] = (f32x4){0.f, 0.f, 0.f, 0.f};
    bf16x8 At[4][2], B0[2][2], B1[2][2];
    const char* cA = (const char*)g.A + (size_t)cur.pm * tstep; const char* cB = (const char*)g.Bt + (size_t)cur.pn * tstep;
    S.a_ready(cur);
    if constexpr (SP2) {
        PG8_STAGE(PG8_SB(0, 0), cB, voffB); PG8_STAGE(PG8_SB(0, 1), cB + hstep, voffB); PG8_STAGE(PG8_SA(0, 0), cA, voffA); PG8_STAGE(PG8_SA(0, 1), cA + hstep, voffA);
        if (wr == 1) PG8_BAR;
        PG8_WAIT_V(2); PG8_BAR;
        PG8_STAGE(PG8_SB(1, 0), cB + kstep, voffB); PG8_STAGE(PG8_SA(1, 0), cA + kstep, voffA); PG8_STAGE(PG8_SB(1, 1), cB + hstep + kstep, voffB);
        PG8_WAIT_V(6); PG8_BAR;
    } else {
        PG8_STAGE(PG8_SB(0, 0), cB, voffB); PG8_STAGE(PG8_SA(0, 0), cA, voffA); PG8_STAGE(PG8_SB(0, 1), cB + hstep, voffB); PG8_STAGE(PG8_SA(0, 1), cA + hstep, voffA);
        if (wr == 1) PG8_BAR;
        PG8_WAIT_V(4); PG8_BAR;
        PG8_STAGE(PG8_SB(1, 0), cB + kstep, voffB); PG8_STAGE(PG8_SA(1, 0), cA + kstep, voffA); PG8_STAGE(PG8_SB(1, 1), cB + hstep + kstep, voffB);
        PG8_WAIT_V(6); PG8_BAR;
    }
    for (;;) {
        const bool has_next = S.next(ui + 1, nxt);
        const char* nA = has_next ? (const char*)g.A + (size_t)nxt.pm * tstep : cA; const char* nB = has_next ? (const char*)g.Bt + (size_t)nxt.pn * tstep : cB;
        for (int t = 0; t < nt; t += 2) {
            const bool last = (t == nt - 2);
            const char* a1 = cA + (size_t)(t + 1) * kstep;
            const char* a2 = last ? nA : cA + (size_t)(t + 2) * kstep; const char* b2 = last ? nB : cB + (size_t)(t + 2) * kstep;
            const char* a3 = a2 + kstep; const char* b3 = b2 + kstep;
            if (last && has_next) S.a_ready(nxt);
            if constexpr (SP2) {
            PG8_LDB(B0, 0, 0); PG8_LDB(B1, 0, 1); PG8_SCHED; PG8_LDA(At, 0, 0); PG8_STAGE(PG8_SA(1, 1), a1 + hstep, voffA);
            PG8_WAIT_V(8); PG8_WAIT_L(0); PG8_BAR; PG8_MMA(0, 0, At, B0); PG8_MMA(0, 1, At, B1); PG8_BAR; PG8_SCHED;
            PG8_LDA(At, 0, 1); PG8_STAGE(PG8_SB(0, 0), b2, voffB); PG8_STAGE(PG8_SB(0, 1), b2 + hstep, voffB); PG8_STAGE(PG8_SA(0, 0), a2, voffA);
            PG8_WAIT_V(8); PG8_WAIT_L(0); PG8_BAR; PG8_MMA(1, 0, At, B0); PG8_MMA(1, 1, At, B1); PG8_BAR; PG8_SCHED;
            PG8_LDB(B0, 1, 0); PG8_LDB(B1, 1, 1); PG8_SCHED; PG8_LDA(At, 1, 0); PG8_STAGE(PG8_SA(0, 1), a2 + hstep, voffA);
            PG8_WAIT_V(8); PG8_WAIT_L(0); PG8_BAR; PG8_MMA(0, 0, At, B0); PG8_MMA(0, 1, At, B1); PG8_BAR; PG8_SCHED;
            PG8_LDA(At, 1, 1); PG8_STAGE(PG8_SB(1, 0), b3, voffB); PG8_STAGE(PG8_SB(1, 1), b3 + hstep, voffB); PG8_STAGE(PG8_SA(1, 0), a3, voffA);
            PG8_WAIT_V(8); PG8_WAIT_L(0); PG8_BAR; PG8_MMA(1, 0, At, B0); PG8_MMA(1, 1, At, B1); PG8_BAR; PG8_SCHED;
            } else {
            PG8_LDB(B0, 0, 0); PG8_SCHED; PG8_LDA(At, 0, 0); PG8_STAGE(PG8_SA(1, 1), a1 + hstep, voffA);
            PG8_WAIT_L(8); PG8_BAR; PG8_WAIT_L(0); PG8_MMA(0, 0, At, B0); PG8_BAR; PG8_SCHED;
            PG8_LDB(B1, 0, 1); PG8_STAGE(PG8_SB(0, 0), b2, voffB);
            PG8_BAR; PG8_WAIT_L(0); PG8_MMA(0, 1, At, B1); PG8_BAR;
            PG8_LDA(At, 0, 1); PG8_STAGE(PG8_SA(0, 0), a2, voffA);
            PG8_BAR; PG8_WAIT_L(0); PG8_MMA(1, 0, At, B0); PG8_BAR; PG8_SCHED;
            PG8_STAGE(PG8_SB(0, 1), b2 + hstep, voffB);
            PG8_WAIT_V(6); PG8_BAR; PG8_MMA(1, 1, At, B1); PG8_BAR;
            PG8_LDB(B0, 1, 0); PG8_SCHED; PG8_LDA(At, 1, 0); PG8_STAGE(PG8_SA(0, 1), a2 + hstep, voffA);
            PG8_WAIT_L(8); PG8_BAR; PG8_WAIT_L(0); PG8_MMA(0, 0, At, B0); PG8_BAR; PG8_SCHED;
            PG8_LDB(B1, 1, 1); PG8_STAGE(PG8_SB(1, 0), b3, voffB);
            PG8_BAR; PG8_WAIT_L(0); PG8_MMA(0, 1, At, B1); PG8_BAR;
            PG8_LDA(At, 1, 1); PG8_STAGE(PG8_SA(1, 0), a3, voffA);
            PG8_BAR; PG8_WAIT_L(0); PG8_MMA(1, 0, At, B0); PG8_BAR; PG8_SCHED;
            PG8_STAGE(PG8_SB(1, 1), b3 + hstep, voffB);
            PG8_WAIT_V(6); PG8_BAR; PG8_MMA(1, 1, At, B1); PG8_BAR;
            }
        }
        if constexpr (ALIGN_EPI) { if (wr == 0) PG8_BAR; }
        if constexpr (!Epi::AFTER_DRAIN) { E(acc, cur, wr, wc, fr, fq); S.done(cur); }
        if (!has_next) break;
#pragma unroll
        for (int a = 0; a < 2; ++a)
#pragma unroll
            for (int b = 0; b < 2; ++b)
#pragma unroll
                for (int m = 0; m < 4; ++m)
#pragma unroll
                    for (int n = 0; n < 2; ++n) acc[a][b][m][n] = (f32x4){0.f, 0.f, 0.f, 0.f};
        cur = nxt; cA = nA; cB = nB; ++ui;
        if constexpr (ALIGN_EPI) { if (wr == 1) PG8_BAR; }
    }
    PG8_WAIT_V(0);
    if constexpr (!ALIGN_EPI) { if (wr == 0) PG8_BAR; }
    PG8_BAR;
    if constexpr (Epi::AFTER_DRAIN) { E.fused(acc, cur, wr, wc, fr, fq, lds, wid, lane); S.done(cur); }
#undef PG8_SA
#undef PG8_SB
#undef PG8_STAGE
#undef PG8_LDA
#undef PG8_LDB
#undef PG8_MMA
#undef PG8_WAIT_V
#undef PG8_WAIT_L
#undef PG8_BAR
#undef PG8_SCHED
}
}
#define PG8_SP2 true
#define PG8_ALIGN true

constexpr int NWAVES = 8;
constexpr int BATCH = 16, SEQ = 2048, DM = 1024, M = BATCH * SEQ;
constexpr int MEMLEN = 256, MM = BATCH * MEMLEN;
constexpr int AH = 8, AHD = 64, AW = 512, NBLK = SEQ / 256;
constexpr int GH = 4, GHK = 64, GHV = 128, GKW = 256, GW = 512, GRANK = 16;
constexpr int XH = 4, XHD = 256;
constexpr int FF = 4096;
constexpr int NIN = 3328;
constexpr float EPS = 1e-6f;
constexpr float LOG2E = 1.4426950408889634f;
constexpr float C2A = 0.125f * LOG2E;
constexpr float C2X = 0.0625f * LOG2E;

constexpr size_t MiB = 1u << 20;
constexpr size_t WS_CTL = 0, CTL_ZERO_BYTES = 256 * 1024;
constexpr size_t WS_SSQ1 = 1 * MiB, WS_SSQ2 = WS_SSQ1 + 128 * 1024, WS_SSQ3 = WS_SSQ2 + 128 * 1024;
constexpr size_t WS_KSUM = WS_SSQ3 + 128 * 1024;
constexpr size_t WS_BIAS = WS_KSUM + 256 * 1024;
constexpr size_t WS_WIN = 2 * MiB, WS_WOUT = 9 * MiB, WS_WXQ = 11 * MiB, WS_WXKV = 13 * MiB, WS_WXO = 17 * MiB, WS_WUP = 19 * MiB, WS_WDN = 27 * MiB;
constexpr size_t WS_GLR = 36 * MiB;
constexpr size_t WS_MN = 38 * MiB, WS_KX = 46 * MiB, WS_VX = 54 * MiB;
constexpr size_t WS_HA = 64 * MiB;
constexpr size_t WS_MIX = 128 * MiB;
constexpr size_t WS_QA = 192 * MiB, WS_KA = 224 * MiB, WS_VA = 256 * MiB, WS_QG = 288 * MiB, WS_KG = 304 * MiB, WS_VG = 320 * MiB, WS_RG = 352 * MiB;
constexpr size_t WS_QX = 192 * MiB, WS_OX = 256 * MiB;
constexpr size_t WS_U = 192 * MiB;
constexpr size_t WS_END = 448 * MiB;
constexpr int CW_BAR = 1024;

constexpr int RING_OFF = 0, RING_BYTES = 131072;
constexpr int LDSCTL_OFF = RING_BYTES, MISC_OFF = LDSCTL_OFF + 320;
constexpr int LDS_BYTES = 147456;
#define GAS __attribute__((address_space(1)))
#define LAS __attribute__((address_space(3)))
typedef unsigned short bf16;
typedef unsigned v4u __attribute__((ext_vector_type(4)));
typedef float f32x4 __attribute__((ext_vector_type(4)));
typedef short bf16x8 __attribute__((ext_vector_type(8)));
typedef GAS unsigned gu32;
typedef GAS unsigned long long gu64;
#define RLX_AGENT __ATOMIC_RELAXED, __HIP_MEMORY_SCOPE_AGENT
#define LDS_WAIT() asm volatile("s_waitcnt lgkmcnt(0)" ::: "memory")
#define VM_WAIT() asm volatile("s_waitcnt vmcnt(0)" ::: "memory")
__device__ __forceinline__ unsigned long long rt() { return __builtin_amdgcn_s_memrealtime(); }
__device__ __forceinline__ unsigned f2bf(float f) { unsigned u = __builtin_bit_cast(unsigned, f); return (u + 0x7fffu + ((u >> 16) & 1u)) >> 16; }
__device__ __forceinline__ unsigned pk2(float lo, float hi) { return f2bf(lo) | (f2bf(hi) << 16); }
#define XB_TMO      128
#define XB_XCNT(j)  (256  + 64 * (j))
#define XB_XSUB(j)  (1280 + 64 * (j))
#define XB_XGEN(j)  (2304 + 64 * (j))
#define XB_TOP      3328
#define XB_TOPGEN   3392
#define XCD_BAR_WORDS 3456
#define XB_SPIN_CAP (1u << 18)

__device__ __forceinline__ unsigned xb_ld(unsigned* p)              { return __hip_atomic_load(p, __ATOMIC_RELAXED, __HIP_MEMORY_SCOPE_AGENT); }
__device__ __forceinline__ unsigned xb_add(unsigned* p, unsigned v) { return __hip_atomic_fetch_add(p, v, __ATOMIC_RELAXED, __HIP_MEMORY_SCOPE_AGENT); }
__device__ __forceinline__ unsigned xb_xcc_id() { return (unsigned)__builtin_amdgcn_s_getreg((3 << 11) | 20) & 0xFu; }
#define XB_SPIN(cond, bar) do { unsigned _sp = 0; while (cond) { __builtin_amdgcn_s_sleep(1); \
    if ((++_sp & 255u) == 0u) { if (xb_ld(&(bar)[XB_TMO])) break; if (_sp > XB_SPIN_CAP) { atomicAdd(&(bar)[XB_TMO], 1u); break; } } } } while (0)

struct XcdBarrier {
    unsigned* bar; unsigned x;
    volatile LAS unsigned* st;
};

__device__ __forceinline__ XcdBarrier xcd_barrier_post(unsigned* bar, volatile LAS unsigned* st) {
    XcdBarrier b; b.bar = bar; b.x = xb_xcc_id(); b.st = st;
    if (threadIdx.x == 0) (void)xb_add(&bar[XB_XCNT(b.x)], 1u);
    return b;
}
__device__ __forceinline__ void xcd_barrier_complete(unsigned* bar, unsigned x, unsigned& nloc, unsigned& nx) {
    const unsigned G = gridDim.x * gridDim.y * gridDim.z;
    unsigned sum, cnt, mine, sp = 0u;
    for (;;) {
        sum = 0u; cnt = 0u; mine = 0u;
#pragma unroll
        for (unsigned j = 0; j < 16; ++j) { const unsigned c = xb_ld(&bar[XB_XCNT(j)]); sum += c; cnt += (c > 0u) ? 1u : 0u; mine = (j == x) ? c : mine; }
        if (sum == G) break;
        __builtin_amdgcn_s_sleep(1);
        if ((++sp & 255u) == 0u) { if (xb_ld(&bar[XB_TMO])) break; if (sp > XB_SPIN_CAP) { atomicAdd(&bar[XB_TMO], 1u); break; } }
    }
    nloc = mine > 0u ? mine : 1u; nx = cnt > 0u ? cnt : 1u;
}

__device__ __forceinline__ void xcd_barrier(const XcdBarrier& b) {
    asm volatile("s_waitcnt vmcnt(0)" ::: "memory");
    __syncthreads();
    if (threadIdx.x == 0) {
        unsigned* bar = b.bar;
        __builtin_amdgcn_s_waitcnt(0);
        unsigned nloc = b.st[0], nx = b.st[1];
        if (nloc == 0u) { xcd_barrier_complete(bar, b.x, nloc, nx); b.st[0] = nloc; b.st[1] = nx; }
        const unsigned old = xb_add(&bar[XB_XSUB(b.x)], 1u);
        const unsigned gen = old / nloc;
        if (old + 1u == (gen + 1u) * nloc) {
            __builtin_amdgcn_fence(__ATOMIC_RELEASE, "agent");
            asm volatile("s_waitcnt vmcnt(0)" ::: "memory");
            const unsigned og = xb_add(&bar[XB_TOP], 1u);
            const unsigned tg = og / nx;
            if (og + 1u == (tg + 1u) * nx) xb_add(&bar[XB_TOPGEN], 1u);
            else XB_SPIN(xb_ld(&bar[XB_TOPGEN]) == tg, bar);
            __builtin_amdgcn_fence(__ATOMIC_ACQUIRE, "agent");
            xb_add(&bar[XB_XGEN(b.x)], 1u);
            asm volatile("s_waitcnt vmcnt(0)" ::: "memory");
        } else {
            XB_SPIN(xb_ld(&bar[XB_XGEN(b.x)]) == gen, bar);
            __builtin_amdgcn_fence(__ATOMIC_ACQUIRE, "agent");
            asm volatile("s_waitcnt vmcnt(0)" ::: "memory");
        }
    }
    __syncthreads();
}
struct Ctx {
    unsigned char* lds;
    LAS unsigned char* ldsl;
    int tid, lane, wave, gw, ngw, G, bid;
    const float *x, *mem, *rp, *norm_mix, *w_in, *w_gate_up, *b_gate, *g_norm, *w_out, *norm_xattn, *norm_mem, *w_xq, *w_xkv, *w_xo, *norm_mlp, *w_up, *w_down, *norm_final;
    float* out; unsigned char* ws;
};
__device__ __forceinline__ float wave_sum(float v) {
#pragma unroll
    for (int o = 1; o < 64; o <<= 1) v += __shfl_xor(v, o);
    return v;
}
__device__ __forceinline__ float wave_max(float v) {
#pragma unroll
    for (int o = 1; o < 64; o <<= 1) v = fmaxf(v, __shfl_xor(v, o));
    return v;
}
__device__ __forceinline__ float bf2f(bf16 b) { return __builtin_bit_cast(float, (unsigned)b << 16); }
__device__ __forceinline__ float bflo(unsigned w) { return __builtin_bit_cast(float, w << 16); }
__device__ __forceinline__ float bfhi(unsigned w) { return __builtin_bit_cast(float, w & 0xffff0000u); }

__host__ __device__ __forceinline__ int rel_bucket(int d) {
    if (d < 16) return d;
    int b = 16;
    b += (d >= 19); b += (d >= 21); b += (d >= 24); b += (d >= 27); b += (d >= 31); b += (d >= 35); b += (d >= 40); b += (d >= 46);
    b += (d >= 52); b += (d >= 59); b += (d >= 67); b += (d >= 77); b += (d >= 87); b += (d >= 99); b += (d >= 113);
    return b;
}

__host__ __device__ __forceinline__ int win_row(int n) { return n < 2560 ? n : (n < 2576 ? 3072 + (n - 2560) : n - 16); }
template <bool MAPWIN>
__device__ __forceinline__ void p0_transpose_item(const float* W, int K, int N, bf16* WT, LAS float* scr, int item, int lane) {
    const int nblk = (N + 31) / 32, kb = item / nblk, nb = item % nblk, k0 = 64 * kb, n0 = 32 * nb;
    const int col = n0 + (lane & 31);
#pragma unroll 8
    for (int i = 0; i < 32; ++i) { const int kk = 2 * i + (lane >> 5); scr[kk * 33 + (lane & 31)] = col < N ? W[(size_t)(k0 + kk) * N + col] : 0.f; }
    LDS_WAIT(); asm volatile("" ::: "memory");
    const int c = lane & 7;
#pragma unroll
    for (int j = 0; j < 4; ++j) { const int n = (lane >> 3) + 8 * j; const LAS float* s = scr + (8 * c) * 33 + n;
        v4u o; o.x = pk2(s[0 * 33], s[1 * 33]); o.y = pk2(s[2 * 33], s[3 * 33]); o.z = pk2(s[4 * 33], s[5 * 33]); o.w = pk2(s[6 * 33], s[7 * 33]);
        if (n0 + n < N) { const int r = MAPWIN ? win_row(n0 + n) : (n0 + n); *(GAS v4u*)(WT + (size_t)r * K + k0 + 8 * c) = o; } }
    LDS_WAIT(); asm volatile("" ::: "memory");
}
__device__ __forceinline__ void rms_row_to_bf16(const float* xrow, const float* gain, bf16* orow, int lane) {
    const GAS f32x4* xr = (const GAS f32x4*)xrow + lane; const GAS f32x4* gr = (const GAS f32x4*)gain + lane;
    f32x4 v[4]; float s = 0.f;
#pragma unroll
    for (int j = 0; j < 4; ++j) { v[j] = xr[64 * j]; s += (v[j].x * v[j].x + v[j].y * v[j].y) + (v[j].z * v[j].z + v[j].w * v[j].w); }
    const float rstd = 1.f / sqrtf(wave_sum(s) * (1.f / 1024.f) + EPS);
    GAS unsigned long long* o8 = (GAS unsigned long long*)orow + lane;
#pragma unroll
    for (int j = 0; j < 4; ++j) { const f32x4 g = gr[64 * j];
        o8[64 * j] = (unsigned long long)pk2(v[j].x * rstd * g.x, v[j].y * rstd * g.y) | ((unsigned long long)pk2(v[j].z * rstd * g.z, v[j].w * rstd * g.w) << 32); }
}
__device__ __forceinline__ void p0_prologue(const Ctx& F) {
    LAS float* scr = (LAS float*)(F.ldsl + RING_OFF + F.wave * 16384);
    unsigned char* ws = F.ws;
    constexpr int I_IN = 16 * 97, I_SQ = 16 * 32, I_KV = 16 * 64, I_UP = 16 * 128, I_DN = 64 * 32;
    constexpr int NITEMS = I_IN + 3 * I_SQ + I_KV + I_UP + I_DN;
    for (int it = F.gw; it < NITEMS; it += F.ngw) {
        int r = it;
        if (r < I_IN) { p0_transpose_item<true>(F.w_in, 1024, 3088, (bf16*)(ws + WS_WIN), scr, r, F.lane); continue; } r -= I_IN;
        if (r < I_SQ) { p0_transpose_item<false>(F.w_out, 1024, 1024, (bf16*)(ws + WS_WOUT), scr, r, F.lane); continue; } r -= I_SQ;
        if (r < I_SQ) { p0_transpose_item<false>(F.w_xq, 1024, 1024, (bf16*)(ws + WS_WXQ), scr, r, F.lane); continue; } r -= I_SQ;
        if (r < I_KV) { p0_transpose_item<false>(F.w_xkv, 1024, 2048, (bf16*)(ws + WS_WXKV), scr, r, F.lane); continue; } r -= I_KV;
        if (r < I_SQ) { p0_transpose_item<false>(F.w_xo, 1024, 1024, (bf16*)(ws + WS_WXO), scr, r, F.lane); continue; } r -= I_SQ;
        if (r < I_UP) { p0_transpose_item<false>(F.w_up, 1024, 4096, (bf16*)(ws + WS_WUP), scr, r, F.lane); continue; } r -= I_UP;
        p0_transpose_item<false>(F.w_down, 4096, 1024, (bf16*)(ws + WS_WDN), scr, r, F.lane);
    }
    const int gt = F.bid * (NWAVES * 64) + F.tid, ngt = F.G * NWAVES * 64;
    {
        GAS v4u* z = (GAS v4u*)(ws + WS_WIN + (size_t)3088 * 2048);
        for (int i = gt; i < 240 * 128; i += ngt) z[i] = (v4u){0u, 0u, 0u, 0u};
    }
    {
        GAS v4u* z = (GAS v4u*)(ws + WS_SSQ1);
        for (int i = gt; i < (3 * 128 * 1024 + 256 * 1024) / 16; i += ngt) z[i] = (v4u){0u, 0u, 0u, 0u};
    }
    if (F.bid == 0) {
        float* bt = (float*)(ws + WS_BIAS);
        for (int i = F.tid; i < 8 * 128; i += NWAVES * 64) { const int h = i >> 7, d = i & 127; bt[i] = F.rp[rel_bucket(d) * 8 + h] * LOG2E; }
    }
    for (int m = F.gw; m < M; m += F.ngw) rms_row_to_bf16(F.x + (size_t)m * DM, F.norm_mix, (bf16*)(ws + WS_HA) + (size_t)m * DM, F.lane);
    for (int m = F.gw; m < MM; m += F.ngw) rms_row_to_bf16(F.mem + (size_t)m * DM, F.norm_mem, (bf16*)(ws + WS_MN) + (size_t)m * DM, F.lane);
}

__device__ __forceinline__ void moba_naive(const Ctx& F) {
    float* sc = (float*)(F.lds + F.wave * 4096);
    const bf16* QA = (const bf16*)(F.ws + WS_QA); const bf16* KA = (const bf16*)(F.ws + WS_KA); const bf16* VA = (const bf16*)(F.ws + WS_VA);
    const float* ksum = (const float*)(F.ws + WS_KSUM); const float* bias = (const float*)(F.ws + WS_BIAS);
    bf16* MIX = (bf16*)(F.ws + WS_MIX);
    const int lane = F.lane;
    for (int task = F.gw; task < M * AH; task += F.ngw) {
        const int h = task / M, row = task % M;
        const int b = row >> 11, t = row & 2047, qb = t >> 8;
        const bf16* qrow = QA + (size_t)row * AW + h * AHD;
        float q[64];
#pragma unroll
        for (int c = 0; c < 8; ++c) { const v4u w = *(const v4u*)(qrow + 8 * c);
            q[8 * c + 0] = bflo(w.x); q[8 * c + 1] = bfhi(w.x); q[8 * c + 2] = bflo(w.y); q[8 * c + 3] = bfhi(w.y);
            q[8 * c + 4] = bflo(w.z); q[8 * c + 5] = bfhi(w.z); q[8 * c + 6] = bflo(w.w); q[8 * c + 7] = bfhi(w.w); }
        const float qd = bf2f(qrow[lane]);
        float gate[8];
#pragma unroll
        for (int j = 0; j < 8; ++j) { const float g = wave_sum(qd * ksum[(size_t)(b * 8 + j) * 512 + h * 64 + lane]); gate[j] = (j < qb) ? g : -INFINITY; }
        unsigned sel = 0u;
#pragma unroll
        for (int r = 0; r < 3; ++r) { int best = -1; float bv = -INFINITY;
#pragma unroll
            for (int j = 0; j < 8; ++j) { const bool ok = !((sel >> j) & 1u) && (j < qb) && (gate[j] > bv); if (ok) { bv = gate[j]; best = j; } }
            if (best >= 0) sel |= 1u << best; }
        sel |= 1u << qb;
        sel = (unsigned)__builtin_amdgcn_readfirstlane((int)sel);
        int nb = 0; float mx = -INFINITY;
        for (int j = 0; j <= qb; ++j) {
            if (!((sel >> j) & 1u)) continue;
            for (int kk = 0; kk < 4; ++kk) {
                const int kpos = j * 256 + kk * 64 + lane; const int d = t - kpos;
                const bf16* krow = KA + (size_t)(b * SEQ + kpos) * AW + h * AHD;
                float s = 0.f;
#pragma unroll
                for (int c = 0; c < 8; ++c) { const v4u w = *(const v4u*)(krow + 8 * c);
                    s += q[8 * c + 0] * bflo(w.x) + q[8 * c + 1] * bfhi(w.x) + q[8 * c + 2] * bflo(w.y) + q[8 * c + 3] * bfhi(w.y)
                       + q[8 * c + 4] * bflo(w.z) + q[8 * c + 5] * bfhi(w.z) + q[8 * c + 6] * bflo(w.w) + q[8 * c + 7] * bfhi(w.w); }
                if (d >= 0) s += bias[h * 128 + (d < 127 ? d : 127)]; else s = -INFINITY;
                sc[nb * 256 + kk * 64 + lane] = s; mx = fmaxf(mx, s);
            }
            ++nb;
        }
        mx = wave_max(mx);
        float sum = 0.f;
        for (int i = lane; i < nb * 256; i += 64) { const float p = exp2f(sc[i] - mx); sc[i] = p; sum += p; }
        sum = wave_sum(sum);
        asm volatile("s_waitcnt lgkmcnt(0)" ::: "memory");
        float o = 0.f; int ib = 0;
        for (int j = 0; j <= qb; ++j) {
            if (!((sel >> j) & 1u)) continue;
            const bf16* vcol = VA + (size_t)(b * SEQ + j * 256) * AW + h * AHD + lane;
#pragma unroll 8
            for (int k = 0; k < 256; ++k) o += sc[ib * 256 + k] * bf2f(vcol[(size_t)k * AW]);
            ++ib;
        }
        MIX[(size_t)row * DM + h * AHD + lane] = (bf16)f2bf(o / sum);
        asm volatile("s_waitcnt lgkmcnt(0)" ::: "memory");
    }
}

__device__ __forceinline__ float log_sigmoid(float z) { return z < 0.f ? z - log1pf(expf(z)) : -log1pf(expf(-z)); }
__device__ __forceinline__ void gla_naive(const Ctx& F) {
    constexpr int TB = 16;
    float* qs = (float*)F.lds;
    float* ks = qs + TB * 64;
    float* as_ = ks + TB * 64;
    float* vs = as_ + TB * 64;
    float* gl = vs + TB * 128;
    float* part = gl + TB * 16;
    float* ob = part + 2 * 4 * 128;
    const bf16* QG = (const bf16*)(F.ws + WS_QG); const bf16* KG = (const bf16*)(F.ws + WS_KG); const bf16* VG = (const bf16*)(F.ws + WS_VG); const bf16* RG = (const bf16*)(F.ws + WS_RG);
    const float* GLR = (const float*)(F.ws + WS_GLR); bf16* MIX = (bf16*)(F.ws + WS_MIX);
    const int tid = F.tid, dv = tid & 127, g4 = tid >> 7;
    for (int chain = F.bid; chain < BATCH * GH; chain += F.G) {
        const int b = chain >> 2, hg = chain & 3;
        float S[16];
#pragma unroll
        for (int i = 0; i < 16; ++i) S[i] = 0.f;
        for (int t0 = 0; t0 < SEQ; t0 += TB) {
            const size_t r0 = (size_t)b * SEQ + t0;
            __syncthreads();
            for (int i = tid; i < TB * 64; i += 512) { const int tt = i >> 6, d = i & 63; qs[i] = bf2f(QG[(r0 + tt) * GKW + hg * 64 + d]); ks[i] = bf2f(KG[(r0 + tt) * GKW + hg * 64 + d]); }
            for (int i = tid; i < TB * 128; i += 512) { const int tt = i >> 7, d = i & 127; vs[i] = bf2f(VG[(r0 + tt) * GW + hg * 128 + d]); }
            if (tid < TB * 16) gl[tid] = GLR[(r0 + (tid >> 4)) * 16 + (tid & 15)];
            __syncthreads();
            for (int i = tid; i < TB * 64; i += 512) { const int tt = i >> 6, d = i & 63; float z = F.b_gate[hg * 64 + d];
#pragma unroll
                for (int r = 0; r < 16; ++r) z += gl[tt * 16 + r] * F.w_gate_up[r * GKW + hg * 64 + d];
                as_[i] = expf(log_sigmoid(z) * (1.0f / 16.0f)); }
            __syncthreads();
            for (int tt = 0; tt < TB; ++tt) {
                float po = 0.f; const float vv = vs[tt * 128 + dv];
#pragma unroll
                for (int i = 0; i < 16; ++i) { const int dk = 16 * g4 + i; S[i] = as_[tt * 64 + dk] * S[i] + ks[tt * 64 + dk] * vv; po += qs[tt * 64 + dk] * S[i]; }
                part[((tt & 1) * 4 + g4) * 128 + dv] = po;
                __syncthreads();
                if (tid < 128) ob[tt * 128 + tid] = (part[((tt & 1) * 4 + 0) * 128 + tid] + part[((tt & 1) * 4 + 1) * 128 + tid]) + (part[((tt & 1) * 4 + 2) * 128 + tid] + part[((tt & 1) * 4 + 3) * 128 + tid]);
            }
            __syncthreads();
#pragma unroll
            for (int k = 0; k < 2; ++k) { const int tt = 2 * F.wave + k; const size_t row = r0 + tt;
                const float o0 = ob[tt * 128 + F.lane], o1 = ob[tt * 128 + 64 + F.lane];
                const float rstd = 1.f / sqrtf(wave_sum(o0 * o0 + o1 * o1) * (1.f / 128.f) + EPS);
                const float r0v = bf2f(RG[row * GW + hg * 128 + F.lane]), r1v = bf2f(RG[row * GW + hg * 128 + 64 + F.lane]);
                const float y0 = o0 * rstd * F.g_norm[F.lane] * (r0v / (1.f + expf(-r0v))), y1 = o1 * rstd * F.g_norm[64 + F.lane] * (r1v / (1.f + expf(-r1v)));
                MIX[row * DM + AW + hg * 128 + F.lane] = (bf16)f2bf(y0); MIX[row * DM + AW + hg * 128 + 64 + F.lane] = (bf16)f2bf(y1); }
        }
        __syncthreads();
    }
}

__device__ __forceinline__ void xattn_naive(const Ctx& F) {
    float* qs = (float*)(F.lds + F.wave * 2048);
    float* sc = qs + 256;
    const bf16* QX = (const bf16*)(F.ws + WS_QX); const bf16* KX = (const bf16*)(F.ws + WS_KX); const bf16* VX = (const bf16*)(F.ws + WS_VX); bf16* OX = (bf16*)(F.ws + WS_OX);
    const int lane = F.lane;
    for (int task = F.gw; task < M * XH; task += F.ngw) {
        const int h = task / M, row = task % M, b = row >> 11;
        {   const unsigned long long w = *(const unsigned long long*)(QX + (size_t)row * DM + h * XHD + 4 * lane);
            qs[4 * lane + 0] = bflo((unsigned)w); qs[4 * lane + 1] = bfhi((unsigned)w); qs[4 * lane + 2] = bflo((unsigned)(w >> 32)); qs[4 * lane + 3] = bfhi((unsigned)(w >> 32)); }
        asm volatile("s_waitcnt lgkmcnt(0)" ::: "memory");
        float mx = -INFINITY;
        for (int kk = 0; kk < 4; ++kk) {
            const bf16* krow = KX + (size_t)(b * MEMLEN + kk * 64 + lane) * DM + h * XHD;
            float s = 0.f;
#pragma unroll 4
            for (int c = 0; c < 32; ++c) { const v4u w = *(const v4u*)(krow + 8 * c); const float* qq = qs + 8 * c;
                s += qq[0] * bflo(w.x) + qq[1] * bfhi(w.x) + qq[2] * bflo(w.y) + qq[3] * bfhi(w.y) + qq[4] * bflo(w.z) + qq[5] * bfhi(w.z) + qq[6] * bflo(w.w) + qq[7] * bfhi(w.w); }
            sc[kk * 64 + lane] = s; mx = fmaxf(mx, s);
        }
        mx = wave_max(mx);
        float sum = 0.f;
        for (int kk = 0; kk < 4; ++kk) { const float p = exp2f(sc[kk * 64 + lane] - mx); sc[kk * 64 + lane] = p; sum += p; }
        sum = wave_sum(sum);
        asm volatile("s_waitcnt lgkmcnt(0)" ::: "memory");
        float o0 = 0.f, o1 = 0.f, o2 = 0.f, o3 = 0.f;
        const bf16* vcol = VX + (size_t)(b * MEMLEN) * DM + h * XHD + 4 * lane;
#pragma unroll 8
        for (int k = 0; k < 256; ++k) { const unsigned long long w = *(const unsigned long long*)(vcol + (size_t)k * DM); const float p = sc[k];
            o0 += p * bflo((unsigned)w); o1 += p * bfhi((unsigned)w); o2 += p * bflo((unsigned)(w >> 32)); o3 += p * bfhi((unsigned)(w >> 32)); }
        const float inv = 1.f / sum;
        *(unsigned long long*)(OX + (size_t)row * DM + h * XHD + 4 * lane) = (unsigned long long)pk2(o0 * inv, o1 * inv) | ((unsigned long long)pk2(o2 * inv, o3 * inv) << 32);
        asm volatile("s_waitcnt lgkmcnt(0)" ::: "memory");
    }
}

__device__ __forceinline__ void final_norm(const Ctx& F) {
    const float* ssq = (const float*)(F.ws + WS_SSQ3);
    for (int m = F.gw; m < M; m += F.ngw) {
        GAS f32x4* xr = (GAS f32x4*)(F.out + (size_t)m * DM) + F.lane; const GAS f32x4* gr = (const GAS f32x4*)F.norm_final + F.lane;
        const float rstd = 1.f / sqrtf(ssq[m] * (1.f / 1024.f) + EPS);
#pragma unroll
        for (int j = 0; j < 4; ++j) { const f32x4 v = xr[64 * j], g = gr[64 * j]; xr[64 * j] = (f32x4){v.x * rstd * g.x, v.y * rstd * g.y, v.z * rstd * g.z, v.w * rstd * g.w}; }
    }
}

constexpr int NPHASE = 10;
struct Args { const float* in[18]; float* out; unsigned char* ws; int ph_lo, ph_hi, li, pad; };
__global__ void __launch_bounds__(NWAVES * 64, 2) mk_fwd(Args args) {
    extern __shared__ __attribute__((aligned(16))) unsigned char lds[];
    Ctx F;
    F.lds = lds; F.ldsl = (LAS unsigned char*)lds;
    F.tid = threadIdx.x; F.lane = F.tid & 63; F.wave = __builtin_amdgcn_readfirstlane(F.tid >> 6);
    F.G = gridDim.x; F.bid = blockIdx.x; F.gw = F.bid * NWAVES + F.wave; F.ngw = F.G * NWAVES;
    F.x = args.in[0]; F.mem = args.in[1]; F.rp = args.in[2]; F.norm_mix = args.in[3]; F.w_in = args.in[4]; F.w_gate_up = args.in[5]; F.b_gate = args.in[6]; F.g_norm = args.in[7];
    F.w_out = args.in[8]; F.norm_xattn = args.in[9]; F.norm_mem = args.in[10]; F.w_xq = args.in[11]; F.w_xkv = args.in[12]; F.w_xo = args.in[13]; F.norm_mlp = args.in[14];
    F.w_up = args.in[15]; F.w_down = args.in[16]; F.norm_final = args.in[17];
    F.out = args.out; F.ws = args.ws;
    unsigned char* ws = args.ws;
    volatile LAS unsigned* MISC = (volatile LAS unsigned*)(F.ldsl + MISC_OFF);
    for (int u = F.tid; u < (LDS_BYTES - LDSCTL_OFF) / 4; u += NWAVES * 64) ((LAS unsigned*)(F.ldsl + LDSCTL_OFF))[u] = 0u;
    __syncthreads();
    const int lo = args.ph_lo, hi = args.ph_hi;
    XcdBarrier bar; bar.bar = (unsigned*)(ws + WS_CTL) + CW_BAR + args.li * XCD_BAR_WORDS; bar.x = 0; bar.st = nullptr;
    if (hi - lo > 1) bar = xcd_barrier_post((unsigned*)(ws + WS_CTL) + CW_BAR + args.li * XCD_BAR_WORDS, MISC + 8);
#define IN(k) (lo <= (k) && (k) < hi)
#define SEAM(k) do { if (IN(k) && IN((k) + 1)) xcd_barrier(bar); } while (0)
    float* ssq1 = (float*)(ws + WS_SSQ1); float* ssq2 = (float*)(ws + WS_SSQ2); float* ssq3 = (float*)(ws + WS_SSQ3);
    bf16* HA = (bf16*)(ws + WS_HA);

    if (IN(0)) { p0_prologue(F); SEAM(0); }

    if (IN(1)) {
        {   pg8::Gemm g{HA, (const bf16*)(ws + WS_WIN), M, NIN, DM}; pg8::StaticOrder S; S.init(M, NIN, F.G, F.bid);
            pg8::EpiInProj E{(bf16*)(ws + WS_QA), (bf16*)(ws + WS_KA), (bf16*)(ws + WS_VA), (bf16*)(ws + WS_QG), (bf16*)(ws + WS_KG), (bf16*)(ws + WS_VG), (bf16*)(ws + WS_RG),
                             (float*)(ws + WS_GLR), (float*)(ws + WS_KSUM), C2A, 0.125f};
            pg8::gemm_phase<pg8::EpiInProj, pg8::StaticOrder, PG8_ALIGN, PG8_SP2>(F.ldsl + RING_OFF, g, S, E); }
        {   pg8::Gemm g{(const bf16*)(ws + WS_MN), (const bf16*)(ws + WS_WXKV), MM, 2048, DM}; pg8::StaticOrder S; S.init(MM, 2048, F.G, F.bid);
            pg8::EpiSplitBf16 E{(bf16*)(ws + WS_KX), (bf16*)(ws + WS_VX), 4, DM};
            pg8::gemm_phase<pg8::EpiSplitBf16, pg8::StaticOrder, PG8_ALIGN, PG8_SP2>(F.ldsl + RING_OFF, g, S, E); }
        SEAM(1);
    }
    if (IN(2)) { gla_naive(F); moba_naive(F); SEAM(2); }
    if (IN(3)) {
        pg8::Gemm g{(const bf16*)(ws + WS_MIX), (const bf16*)(ws + WS_WOUT), M, DM, DM}; pg8::StaticOrder S; S.init(M, DM, F.G, F.bid);
        pg8::EpiResidual<true> E{F.x, F.out, HA, F.norm_xattn, ssq1};
        pg8::gemm_phase<pg8::EpiResidual<true>, pg8::StaticOrder, PG8_ALIGN, PG8_SP2>(F.ldsl + RING_OFF, g, S, E);
        SEAM(3);
    }
    if (IN(4)) {
        pg8::Gemm g{HA, (const bf16*)(ws + WS_WXQ), M, DM, DM}; pg8::StaticOrder S; S.init(M, DM, F.G, F.bid);
        pg8::EpiRowScale<0> E{(bf16*)(ws + WS_QX), DM, ssq1, EPS, C2X};
        pg8::gemm_phase<pg8::EpiRowScale<0>, pg8::StaticOrder, PG8_ALIGN, PG8_SP2>(F.ldsl + RING_OFF, g, S, E);
        SEAM(4);
    }
    if (IN(5)) { xattn_naive(F); SEAM(5); }
    if (IN(6)) {
        pg8::Gemm g{(const bf16*)(ws + WS_OX), (const bf16*)(ws + WS_WXO), M, DM, DM}; pg8::StaticOrder S; S.init(M, DM, F.G, F.bid);
        pg8::EpiResidual<true> E{F.out, F.out, HA, F.norm_mlp, ssq2};
        pg8::gemm_phase<pg8::EpiResidual<true>, pg8::StaticOrder, PG8_ALIGN, PG8_SP2>(F.ldsl + RING_OFF, g, S, E);
        SEAM(6);
    }
    if (IN(7)) {
        pg8::Gemm g{HA, (const bf16*)(ws + WS_WUP), M, FF, DM}; pg8::StaticOrder S; S.init(M, FF, F.G, F.bid);
        pg8::EpiRowScale<1> E{(bf16*)(ws + WS_U), FF, ssq2, EPS, 1.0f};
        pg8::gemm_phase<pg8::EpiRowScale<1>, pg8::StaticOrder, PG8_ALIGN, PG8_SP2>(F.ldsl + RING_OFF, g, S, E);
        SEAM(7);
    }
    if (IN(8)) {
        pg8::Gemm g{(const bf16*)(ws + WS_U), (const bf16*)(ws + WS_WDN), M, DM, FF}; pg8::StaticOrder S; S.init(M, DM, F.G, F.bid);
        pg8::EpiResidual<false> E{F.out, F.out, nullptr, nullptr, ssq3};
        pg8::gemm_phase<pg8::EpiResidual<false>, pg8::StaticOrder, PG8_ALIGN, PG8_SP2>(F.ldsl + RING_OFF, g, S, E);
        SEAM(8);
    }
    if (IN(9)) { final_norm(F); }
#undef IN
#undef SEAM
}

#ifndef MK_CUTS
#define MK_CUTS 0x0
#endif
extern "C" void kernel_launch(void* const* d_in, const int* in_sizes, int n_in, void* d_out, int out_size, void* d_ws, size_t ws_size, hipStream_t stream) {
    static int grid = 0;
    if (grid == 0) {
        if (n_in != 18 || out_size != M * DM || ws_size < WS_END) { fprintf(stderr, "kernel_launch: unexpected shapes (n_in %d out %d ws %zu)\n", n_in, out_size, ws_size); grid = -1; return; }
        int dev = 0, cus = 0;
        if (hipGetDevice(&dev) != hipSuccess || hipDeviceGetAttribute(&cus, hipDeviceAttributeMultiprocessorCount, dev) != hipSuccess) { grid = -1; return; }
        if (hipFuncSetAttribute((const void*)mk_fwd, hipFuncAttributeMaxDynamicSharedMemorySize, LDS_BYTES) != hipSuccess) { fprintf(stderr, "kernel_launch: hipFuncSetAttribute failed\n"); grid = -1; return; }
        (void)hipGetLastError();
        grid = cus;
    }
    if (grid < 0) return;
    (void)hipMemsetAsync((char*)d_ws + WS_CTL, 0, CTL_ZERO_BYTES, stream);
    Args a{};
    for (int i = 0; i < 18; ++i) a.in[i] = (const float*)d_in[i];
    a.out = (float*)d_out; a.ws = (unsigned char*)d_ws;
    int lo = 0, li = 0;
    for (int k = 0; k < NPHASE; ++k) {
        if (k == NPHASE - 1 || ((MK_CUTS >> k) & 1)) {
            a.ph_lo = lo; a.ph_hi = k + 1; a.li = li++;
            hipLaunchKernelGGL(mk_fwd, dim3(grid), dim3(NWAVES * 64), LDS_BYTES, stream, a);
            lo = k + 1;
        }
    }
}
```

```cpp
#include <hip/hip_runtime.h>
#include <cstdio>
#include <cstdint>
#include <cmath>
namespace pg8 {
#define PG8_LAS __attribute__((address_space(3)))
typedef unsigned short bf16_t;
typedef short bf16x8 __attribute__((ext_vector_type(8)));
typedef float f32x4 __attribute__((ext_vector_type(4)));
typedef unsigned u32x4 __attribute__((ext_vector_type(4)));
constexpr int BM = 256, BK = 64, HALF = 128, HTB = HALF * BK * 2  , STAGE_BYTES = 8 * HTB, NXCD = 8, WGM = 8;

__host__ __device__ __forceinline__ int lds_byte(int r, int c) { const int st = (r >> 4) * 2 + (c >> 5), rr = r & 15, cc = c & 31, ob = rr * 64 + cc * 2; return st * 1024 + (ob ^ (((ob >> 9) & 1) << 5)); }
__host__ __device__ __forceinline__ void stage_rc(int b, int& R, int& C) { const int st = b / 1024, sb = b % 1024, swz = sb ^ (((sb >> 9) & 1) << 5); R = (st >> 1) * 16 + swz / 64; C = (st & 1) * 32 + (swz % 64) / 2; }
__host__ __device__ __forceinline__ int perm32(int rho) { const int n = rho >> 4, i = rho & 15; return 8 * (i >> 2) + 4 * n + (i & 3); }

struct Unit { int pm, pn; };
struct Gemm { const bf16_t* A; const bf16_t* Bt; int M, N, K; };

struct StaticOrder {
    int nM, nN, nwg, G, c;
    __host__ __device__ void init(int M, int N, int G_, int c_) { nM = M / BM; nN = N / BM; nwg = nM * nN; G = G_; c = c_; }
    __host__ __device__ bool next(int i, Unit& u) const {
        const long L = (long)i * G + c; if (L >= nwg) return false;
        int wgid = (int)L; { const int q = nwg / NXCD, r = nwg % NXCD, xcd = wgid % NXCD, off = wgid / NXCD; wgid = (xcd < r ? xcd * (q + 1) : r * (q + 1) + (xcd - r) * q) + off; }
        const int nig = WGM * nN, gid = wgid / nig, fm = gid * WGM, gsz = (nM - fm) < WGM ? (nM - fm) : WGM;
        u.pm = fm + ((wgid % nig) % gsz); u.pn = (wgid % nig) / gsz; return true;
    }
    __device__ __forceinline__ void a_ready(const Unit&) const {}
    __device__ __forceinline__ void done(const Unit&) const {}
};
__device__ __forceinline__ unsigned cvt_pk_bf16(float lo, float hi) { unsigned r; asm volatile("v_cvt_pk_bf16_f32 %0, %1, %2" : "=v"(r) : "v"(lo), "v"(hi)); return r; }
typedef float f32x2 __attribute__((ext_vector_type(2)));
typedef unsigned u32x2e __attribute__((ext_vector_type(2)));
__device__ __forceinline__ u32x4 pack8(f32x4 v0, f32x4 v1) { u32x4 w; w.x = cvt_pk_bf16(v0[0], v0[1]); w.y = cvt_pk_bf16(v0[2], v0[3]); w.z = cvt_pk_bf16(v1[0], v1[1]); w.w = cvt_pk_bf16(v1[2], v1[3]); return w; }

struct EpiInProj {
    static constexpr bool PERM = true, AFTER_DRAIN = false;
    bf16_t *qa, *ka, *va, *qg, *kg, *vg, *rg; float* glr; float* ksum; float qa_scale, qg_scale;
    __device__ __forceinline__ void operator()(const f32x4 (&acc)[2][2][4][2], const Unit& u, int wr, int wc, int fr, int fq) const {
        const int pn = u.pn; const int row0 = u.pm * BM + wr * 64 + fr; const int cin = wc * 32 + 8 * fq;
        if (pn == 12) {
            if (wc == 0 && fq < 2) {
#pragma unroll
                for (int ai = 0; ai < 2; ++ai)
#pragma unroll
                    for (int m = 0; m < 4; ++m) { float* p = glr + (size_t)(row0 + ai * HALF + m * 16) * 16 + 8 * fq; *(f32x4*)p = acc[ai][0][m][0]; *(f32x4*)(p + 4) = acc[ai][0][m][1]; }
            }
            return;
        }
        bf16_t* base; int pitch, coff; float sc = 1.f;
        if (pn < 2) { base = qa; pitch = 512; coff = pn * 256; sc = qa_scale; }
        else if (pn < 4) { base = ka; pitch = 512; coff = (pn - 2) * 256; }
        else if (pn < 6) { base = va; pitch = 512; coff = (pn - 4) * 256; }
        else if (pn == 6) { base = qg; pitch = 256; coff = 0; sc = qg_scale; }
        else if (pn == 7) { base = kg; pitch = 256; coff = 0; }
        else if (pn < 10) { base = vg; pitch = 512; coff = (pn - 8) * 256; }
        else { base = rg; pitch = 512; coff = (pn - 10) * 256; }
#pragma unroll
        for (int ai = 0; ai < 2; ++ai)
#pragma unroll
            for (int m = 0; m < 4; ++m) { bf16_t* rowp = base + (size_t)(row0 + ai * HALF + m * 16) * pitch + coff + cin;
#pragma unroll
                for (int bj = 0; bj < 2; ++bj) *(u32x4*)(rowp + bj * HALF) = pack8(acc[ai][bj][m][0] * sc, acc[ai][bj][m][1] * sc); }
        if (pn == 2 || pn == 3) {
            float* kp = ksum + (size_t)u.pm * 512 + (pn - 2) * 256 + cin;
#pragma unroll
            for (int bj = 0; bj < 2; ++bj) {
                f32x4 s0 = {0.f, 0.f, 0.f, 0.f}, s1 = {0.f, 0.f, 0.f, 0.f};
#pragma unroll
                for (int ai = 0; ai < 2; ++ai)
#pragma unroll
                    for (int m = 0; m < 4; ++m) { s0 += acc[ai][bj][m][0]; s1 += acc[ai][bj][m][1]; }
#pragma unroll
                for (int e = 0; e < 4; ++e) {
#pragma unroll
                    for (int o = 1; o < 16; o <<= 1) { s0[e] += __shfl_xor(s0[e], o); s1[e] += __shfl_xor(s1[e], o); }
                }
                if (fr == 0) {
#pragma unroll
                    for (int e = 0; e < 4; ++e) { atomicAdd(kp + bj * HALF + e, s0[e]); atomicAdd(kp + bj * HALF + 4 + e, s1[e]); }
                }
            }
        }
    }
};

struct EpiSplitBf16 {
    static constexpr bool PERM = true, AFTER_DRAIN = false;
    bf16_t *o0, *o1; int split_tiles; int pitch;
    __device__ __forceinline__ void operator()(const f32x4 (&acc)[2][2][4][2], const Unit& u, int wr, int wc, int fr, int fq) const {
        const int row0 = u.pm * BM + wr * 64 + fr; const int t = u.pn >= split_tiles ? 1 : 0;
        bf16_t* base = t ? o1 : o0; const int col0 = (u.pn - t * split_tiles) * BM + wc * 32 + 8 * fq;
#pragma unroll
        for (int ai = 0; ai < 2; ++ai)
#pragma unroll
            for (int m = 0; m < 4; ++m) { bf16_t* rowp = base + (size_t)(row0 + ai * HALF + m * 16) * pitch + col0;
#pragma unroll
                for (int bj = 0; bj < 2; ++bj) *(u32x4*)(rowp + bj * HALF) = pack8(acc[ai][bj][m][0], acc[ai][bj][m][1]); }
    }
};

template <bool WITH_AN> struct EpiResidual {
    static constexpr bool PERM = true, AFTER_DRAIN = false;
    const float* xb; float* xo; bf16_t* an; const float* gain; float* ssq;
    __device__ __forceinline__ void operator()(const f32x4 (&acc)[2][2][4][2], const Unit& u, int wr, int wc, int fr, int fq) const {
        const int row0 = u.pm * BM + wr * 64 + fr; const int col0 = u.pn * BM + wc * 32 + 8 * fq;
        f32x4 g[2][2];
        if (WITH_AN) {
#pragma unroll
            for (int bj = 0; bj < 2; ++bj) { g[bj][0] = *(const f32x4*)(gain + col0 + bj * HALF); g[bj][1] = *(const f32x4*)(gain + col0 + bj * HALF + 4); }
        }
#pragma unroll
        for (int ai = 0; ai < 2; ++ai)
#pragma unroll
            for (int m = 0; m < 4; ++m) { const int row = row0 + ai * HALF + m * 16; const size_t off = (size_t)row * 1024 + col0; float sq = 0.f;
#pragma unroll
                for (int bj = 0; bj < 2; ++bj) {
                    const f32x4 b0 = *(const f32x4*)(xb + off + bj * HALF), b1 = *(const f32x4*)(xb + off + bj * HALF + 4);
                    const f32x4 v0 = b0 + acc[ai][bj][m][0], v1 = b1 + acc[ai][bj][m][1];
                    *(f32x4*)(xo + off + bj * HALF) = v0; *(f32x4*)(xo + off + bj * HALF + 4) = v1;
                    sq += (v0[0] * v0[0] + v0[1] * v0[1]) + (v0[2] * v0[2] + v0[3] * v0[3]) + (v1[0] * v1[0] + v1[1] * v1[1]) + (v1[2] * v1[2] + v1[3] * v1[3]);
                    if (WITH_AN) *(u32x4*)(an + off + bj * HALF) = pack8(v0 * g[bj][0], v1 * g[bj][1]);
                }
                sq += __shfl_xor(sq, 16); sq += __shfl_xor(sq, 32);
                if (fq == 0) atomicAdd(ssq + row, sq);
            }
    }
};

template <int ACT> struct EpiRowScale {
    static constexpr bool PERM = true, AFTER_DRAIN = false;
    bf16_t* out; int pitch; const float* ssq; float eps, scale;
    __device__ __forceinline__ void operator()(const f32x4 (&acc)[2][2][4][2], const Unit& u, int wr, int wc, int fr, int fq) const {
        const int row0 = u.pm * BM + wr * 64 + fr; const int col0 = u.pn * BM + wc * 32 + 8 * fq;
#pragma unroll
        for (int ai = 0; ai < 2; ++ai)
#pragma unroll
            for (int m = 0; m < 4; ++m) { const int row = row0 + ai * HALF + m * 16; const float rs = __builtin_amdgcn_rsqf(ssq[row] * (1.0f / 1024.0f) + eps) ;
                bf16_t* rowp = out + (size_t)row * pitch + col0;
#pragma unroll
                for (int bj = 0; bj < 2; ++bj) { f32x4 v0 = acc[ai][bj][m][0] * rs, v1 = acc[ai][bj][m][1] * rs;
                    if (ACT == 1) {
#pragma unroll
                        for (int e = 0; e < 4; ++e) { const float a = fmaxf(v0[e], 0.f), b = fmaxf(v1[e], 0.f); v0[e] = a * a; v1[e] = b * b; }
                    }
                    *(u32x4*)(rowp + bj * HALF) = pack8(v0 * scale, v1 * scale); }
            }
    }
};
template <class Epi, class Sched, bool ALIGN_EPI = false, bool SP2 = false>
__device__ __forceinline__ void gemm_phase(PG8_LAS unsigned char* lds, const Gemm g, const Sched& S, const Epi& E) {
    const int tid = threadIdx.x, wid = __builtin_amdgcn_readfirstlane(tid >> 6), lane = tid & 63, wr = wid >> 2, wc = wid & 3, fr = lane & 15, fq = lane >> 4;
    const int K = g.K, nt = K / BK;
    unsigned voffA[2], voffB[2];
#pragma unroll
    for (int i = 0; i < 2; ++i) { int R, C; stage_rc(tid * 16 + i * 8192, R, C); const int Rb = Epi::PERM ? ((R & ~31) + perm32(R & 31)) : R;
        voffA[i] = (unsigned)(R * K + C) * 2u; voffB[i] = (unsigned)(Rb * K + C) * 2u; }
    const size_t kstep = (size_t)(BK * 2);
    const size_t hstep = (size_t)HALF * K * 2;
    const size_t tstep = 2 * hstep;
    const unsigned ldsw = (unsigned)wid * 1024u;
    const int aoff = lds_byte(wr * 64 + fr, fq * 8), boff = lds_byte(wc * 32 + fr, fq * 8);
#define PG8_SA(b, h) (((b) * 2 + (h)) * HTB)
#define PG8_SB(b, h) ((4 + (b) * 2 + (h)) * HTB)
#define PG8_STAGE(bufoff, gbase, voff) do { _Pragma("unroll") for (int _i = 0; _i < 2; ++_i) \
        __builtin_amdgcn_global_load_lds((const unsigned*)((const char*)(gbase) + (voff)[_i]), (PG8_LAS unsigned*)(lds + (bufoff) + ldsw + _i * 8192), 16, 0, 0); } while (0)
#define PG8_LDA(dst, b, h) do { _Pragma("unroll") for (int m = 0; m < 4; ++m) _Pragma("unroll") for (int k = 0; k < 2; ++k) dst[m][k] = *(const PG8_LAS bf16x8*)(lds + PG8_SA(b, h) + aoff + m * 2048 + k * 1024); } while (0)
#define PG8_LDB(dst, b, h) do { _Pragma("unroll") for (int n = 0; n < 2; ++n) _Pragma("unroll") for (int k = 0; k < 2; ++k) dst[n][k] = *(const PG8_LAS bf16x8*)(lds + PG8_SB(b, h) + boff + n * 2048 + k * 1024); } while (0)
#define PG8_MMA(ai, bj, At, Bt) do { __builtin_amdgcn_s_setprio(1); _Pragma("unroll") for (int m = 0; m < 4; ++m) _Pragma("unroll") for (int n = 0; n < 2; ++n) _Pragma("unroll") for (int k = 0; k < 2; ++k) \
        acc[ai][bj][m][n] = __builtin_amdgcn_mfma_f32_16x16x32_bf16(Bt[n][k], At[m][k], acc[ai][bj][m][n], 0, 0, 0); __builtin_amdgcn_s_setprio(0); } while (0)
#define PG8_WAIT_V(n) asm volatile("s_waitcnt vmcnt(" #n ")" ::: "memory")
#define PG8_WAIT_L(n) asm volatile("s_waitcnt lgkmcnt(" #n ")" ::: "memory")
#define PG8_BAR __builtin_amdgcn_s_barrier()
#define PG8_SCHED __builtin_amdgcn_sched_barrier(0)
    Unit cur, nxt; int ui = 0;
    if (!S.next(0, cur)) return;
    f32x4 acc[2][2][4][2];
#pragma unroll
    for (int a = 0; a < 2; ++a)
#pragma unroll
        for (int b = 0; b < 2; ++b)
#pragma unroll
            for (int m = 0; m < 4; ++m)
#pragma unroll
                for (int n = 0; n < 2; ++n) acc[a][b][m][n] = (f32x4){0.f, 0.f, 0.f, 0.f};
    bf16x8 At[4][2], B0[2][2], B1[2][2];
    const char* cA = (const char*)g.A + (size_t)cur.pm * tstep; const char* cB = (const char*)g.Bt + (size_t)cur.pn * tstep;
    S.a_ready(cur);
    if constexpr (SP2) {
        PG8_STAGE(PG8_SB(0, 0), cB, voffB); PG8_STAGE(PG8_SB(0, 1), cB + hstep, voffB); PG8_STAGE(PG8_SA(0, 0), cA, voffA); PG8_STAGE(PG8_SA(0, 1), cA + hstep, voffA);
        if (wr == 1) PG8_BAR;
        PG8_WAIT_V(2); PG8_BAR;
        PG8_STAGE(PG8_SB(1, 0), cB + kstep, voffB); PG8_STAGE(PG8_SA(1, 0), cA + kstep, voffA); PG8_STAGE(PG8_SB(1, 1), cB + hstep + kstep, voffB);
        PG8_WAIT_V(6); PG8_BAR;
    } else {
        PG8_STAGE(PG8_SB(0, 0), cB, voffB); PG8_STAGE(PG8_SA(0, 0), cA, voffA); PG8_STAGE(PG8_SB(0, 1), cB + hstep, voffB); PG8_STAGE(PG8_SA(0, 1), cA + hstep, voffA);
        if (wr == 1) PG8_BAR;
        PG8_WAIT_V(4); PG8_BAR;
        PG8_STAGE(PG8_SB(1, 0), cB + kstep, voffB); PG8_STAGE(PG8_SA(1, 0), cA + kstep, voffA); PG8_STAGE(PG8_SB(1, 1), cB + hstep + kstep, voffB);
        PG8_WAIT_V(6); PG8_BAR;
    }
    for (;;) {
        const bool has_next = S.next(ui + 1, nxt);
        const char* nA = has_next ? (const char*)g.A + (size_t)nxt.pm * tstep : cA; const char* nB = has_next ? (const char*)g.Bt + (size_t)nxt.pn * tstep : cB;
        for (int t = 0; t < nt; t += 2) {
            const bool last = (t == nt - 2);
            const char* a1 = cA + (size_t)(t + 1) * kstep;
            const char* a2 = last ? nA : cA + (size_t)(t + 2) * kstep; const char* b2 = last ? nB : cB + (size_t)(t + 2) * kstep;
            const char* a3 = a2 + kstep; const char* b3 = b2 + kstep;
            if (last && has_next) S.a_ready(nxt);
            if constexpr (SP2) {
            PG8_LDB(B0, 0, 0); PG8_LDB(B1, 0, 1); PG8_SCHED; PG8_LDA(At, 0, 0); PG8_STAGE(PG8_SA(1, 1), a1 + hstep, voffA);
            PG8_WAIT_V(8); PG8_WAIT_L(0); PG8_BAR; PG8_MMA(0, 0, At, B0); PG8_MMA(0, 1, At, B1); PG8_BAR; PG8_SCHED;
            PG8_LDA(At, 0, 1); PG8_STAGE(PG8_SB(0, 0), b2, voffB); PG8_STAGE(PG8_SB(0, 1), b2 + hstep, voffB); PG8_STAGE(PG8_SA(0, 0), a2, voffA);
            PG8_WAIT_V(8); PG8_WAIT_L(0); PG8_BAR; PG8_MMA(1, 0, At, B0); PG8_MMA(1, 1, At, B1); PG8_BAR; PG8_SCHED;
            PG8_LDB(B0, 1, 0); PG8_LDB(B1, 1, 1); PG8_SCHED; PG8_LDA(At, 1, 0); PG8_STAGE(PG8_SA(0, 1), a2 + hstep, voffA);
            PG8_WAIT_V(8); PG8_WAIT_L(0); PG8_BAR; PG8_MMA(0, 0, At, B0); PG8_MMA(0, 1, At, B1); PG8_BAR; PG8_SCHED;
            PG8_LDA(At, 1, 1); PG8_STAGE(PG8_SB(1, 0), b3, voffB); PG8_STAGE(PG8_SB(1, 1), b3 + hstep, voffB); PG8_STAGE(PG8_SA(1, 0), a3, voffA);
            PG8_WAIT_V(8); PG8_WAIT_L(0); PG8_BAR; PG8_MMA(1, 0, At, B0); PG8_MMA(1, 1, At, B1); PG8_BAR; PG8_SCHED;
            } else {
            PG8_LDB(B0, 0, 0); PG8_SCHED; PG8_LDA(At, 0, 0); PG8_STAGE(PG8_SA(1, 1), a1 + hstep, voffA);
            PG8_WAIT_L(8); PG8_BAR; PG8_WAIT_L(0); PG8_MMA(0, 0, At, B0); PG8_BAR; PG8_SCHED;
            PG8_LDB(B1, 0, 1); PG8_STAGE(PG8_SB(0, 0), b2, voffB);
            PG8_BAR; PG8_WAIT_L(0); PG8_MMA(0, 1, At, B1); PG8_BAR;
            PG8_LDA(At, 0, 1); PG8_STAGE(PG8_SA(0, 0), a2, voffA);
            PG8_BAR; PG8_WAIT_L(0); PG8_MMA(1, 0, At, B0); PG8_BAR; PG8_SCHED;
            PG8_STAGE(PG8_SB(0, 1), b2 + hstep, voffB);
            PG8_WAIT_V(6); PG8_BAR; PG8_MMA(1, 1, At, B1); PG8_BAR;
            PG8_LDB(B0, 1, 0); PG8_SCHED; PG8_LDA(At, 1, 0); PG8_STAGE(PG8_SA(0, 1), a2 + hstep, voffA);
            PG8_WAIT_L(8); PG8_BAR; PG8_WAIT_L(0); PG8_MMA(0, 0, At, B0); PG8_BAR; PG8_SCHED;
            PG8_LDB(B1, 1, 1); PG8_STAGE(PG8_SB(1, 0), b3, voffB);
            PG8_BAR; PG8_WAIT_L(0); PG8_MMA(0, 1, At, B1); PG8_BAR;
            PG8_LDA(At, 1, 1); PG8_STAGE(PG8_SA(1, 0), a3, voffA);
            PG8_BAR; PG8_WAIT_L(0); PG8_MMA(1, 0, At, B0); PG8_BAR; PG8_SCHED;
            PG8_STAGE(PG8_SB(1, 1), b3 + hstep, voffB);
            PG8_WAIT_V(6); PG8_BAR; PG8_MMA(1, 1, At, B1); PG8_BAR;
            }
        }
        if constexpr (ALIGN_EPI) { if (wr == 0) PG8_BAR; }
        if constexpr (!Epi::AFTER_DRAIN) { E(acc, cur, wr, wc, fr, fq); S.done(cur); }
        if (!has_next) break;
#pragma unroll
        for (int a = 0; a < 2; ++a)
#pragma unroll
            for (int b = 0; b < 2; ++b)
#pragma unroll
                for (int m = 0; m < 4; ++m)
#pragma unroll
                    for (int n = 0; n < 2; ++n) acc[a][b][m][n] = (f32x4){0.f, 0.f, 0.f, 0.f};
        cur = nxt; cA = nA; cB = nB; ++ui;
        if constexpr (ALIGN_EPI) { if (wr == 1) PG8_BAR; }
    }
    PG8_WAIT_V(0);
    if constexpr (!ALIGN_EPI) { if (wr == 0) PG8_BAR; }
    PG8_BAR;
    if constexpr (Epi::AFTER_DRAIN) { E.fused(acc, cur, wr, wc, fr, fq, lds, wid, lane); S.done(cur); }
#undef PG8_SA
#undef PG8_SB
#undef PG8_STAGE
#undef PG8_LDA
#undef PG8_LDB
#undef PG8_MMA
#undef PG8_WAIT_V
#undef PG8_WAIT_L
#undef PG8_BAR
#undef PG8_SCHED
}
}
#include <hip/hip_bf16.h>
#include <cmath>
namespace attn_body {
using bf16=__hip_bfloat16;
using bf16x8=__attribute__((ext_vector_type(8)))short;
using s16x4=__attribute__((ext_vector_type(4)))short;
using f32x16=__attribute__((ext_vector_type(16)))float;
using u32x4=__attribute__((ext_vector_type(4)))unsigned;
constexpr int BATCH=16,NHEAD=8,SEQ=2048,D=64,DM=NHEAD*D,OPITCH=1024;
constexpr int NW=8,QBLK=32,QB=QBLK*NW,KVBLK=64,NQB=SEQ/QB;
constexpr int ATTN_PITCH=DM, ATTN_UNIT_ROWS=QB;
__device__ __forceinline__ int crow(int r,int hi){return (r&3)+8*(r>>2)+4*hi;}
#define SBAR() __builtin_amdgcn_sched_barrier(0)
constexpr int NSLOT=3, SLOTB=8192;
constexpr int LDS_K=0, LDS_V=NSLOT*SLOTB, LDS_WS=2*NSLOT*SLOTB, LDS_OST=LDS_WS+NW*64*4, LDS_LUT=LDS_OST+NW*4096, LDS_KMS=LDS_LUT+4096, LDS_BYTES=LDS_KMS+2048;
constexpr float C2=0.125f*1.4426950408889634f;
__device__ __forceinline__ void glds16(const void*gsrc,unsigned lds_dst){unsigned keep;
  asm volatile("s_mov_b32 %0, m0\n\ts_mov_b32 m0, %2\n\ts_nop 0\n\tglobal_load_lds_dwordx4 %1, off\n\ts_mov_b32 m0, %0":"=&s"(keep):"v"(gsrc),"s"(lds_dst):"memory");}
__device__ __forceinline__ float max3f(float a,float b,float c){float r;asm("v_max3_f32 %0, %1, %2, %3":"=v"(r):"v"(a),"v"(b),"v"(c));return r;}
__device__ __forceinline__ float max2f(float a,float b){float r;asm("v_max_f32_e32 %0, %1, %2":"=v"(r):"v"(a),"v"(b));return r;}
__device__ __forceinline__ float fadd_s(float a,float b){float r;asm("v_add_f32_e32 %0, %1, %2":"=v"(r):"v"(a),"v"(b));return r;}
__device__ __forceinline__ float fsub_s(float a,float b){float r;asm("v_sub_f32_e32 %0, %1, %2":"=v"(r):"v"(a),"v"(b));return r;}
typedef float f32x2_t __attribute__((ext_vector_type(2))); typedef __bf16 bf16x2_t __attribute__((ext_vector_type(2)));
__device__ __forceinline__ unsigned cvtpk_s(float lo,float hi){f32x2_t v={lo,hi};bf16x2_t b=__builtin_convertvector(v,bf16x2_t);return __builtin_bit_cast(unsigned,b);}
#define WAIT_BAR(N) asm volatile("s_waitcnt vmcnt(" #N ") lgkmcnt(0)\n\ts_barrier":::"memory")

__device__ __forceinline__ void qkt(f32x16&p0,f32x16&p1,const char*Kslot,const bf16x8*qr,const f32x16&negm,int r32,int hi){
  const char*kb=Kslot+hi*1024+r32*16;
  #pragma unroll
  for(int d0=0;d0<4;++d0){
    const bf16x8 b0=*reinterpret_cast<const bf16x8*>(kb+d0*2048);
    const bf16x8 b1=*reinterpret_cast<const bf16x8*>(kb+d0*2048+512);
    if(d0==0){p0=__builtin_amdgcn_mfma_f32_32x32x16_bf16(b0,qr[0],negm,0,0,0);p1=__builtin_amdgcn_mfma_f32_32x32x16_bf16(b1,qr[0],negm,0,0,0);}
    else{p0=__builtin_amdgcn_mfma_f32_32x32x16_bf16(b0,qr[d0],p0,0,0,0);p1=__builtin_amdgcn_mfma_f32_32x32x16_bf16(b1,qr[d0],p1,0,0,0);}}
}
typedef __attribute__((address_space(3))) const char* lds_cptr;
typedef short v4i16_t __attribute__((ext_vector_type(4)));
__device__ __forceinline__ void kload8(bf16x8*kf,lds_cptr kp){
  kf[0]=*(const __attribute__((address_space(3))) bf16x8*)(kp);      kf[1]=*(const __attribute__((address_space(3))) bf16x8*)(kp+512);
  kf[2]=*(const __attribute__((address_space(3))) bf16x8*)(kp+2048); kf[3]=*(const __attribute__((address_space(3))) bf16x8*)(kp+2560);
  kf[4]=*(const __attribute__((address_space(3))) bf16x8*)(kp+4096); kf[5]=*(const __attribute__((address_space(3))) bf16x8*)(kp+4608);
  kf[6]=*(const __attribute__((address_space(3))) bf16x8*)(kp+6144); kf[7]=*(const __attribute__((address_space(3))) bf16x8*)(kp+6656);
}
__device__ __forceinline__ void kload2(bf16x8*kf,lds_cptr kp,int j){ kf[2*j]=*(const __attribute__((address_space(3))) bf16x8*)(kp+j*2048); kf[2*j+1]=*(const __attribute__((address_space(3))) bf16x8*)(kp+j*2048+512); }
__device__ __forceinline__ s16x4 vtr(lds_cptr p){ return __builtin_bit_cast(s16x4,__builtin_amdgcn_ds_read_tr16_b64_v4i16((__attribute__((address_space(3))) v4i16_t*)p)); }
__device__ __forceinline__ float rowmax(const f32x16&p0,const f32x16&p1){
  float a=max3f(p0[0],p0[1],p1[0]),b=max3f(p0[2],p0[3],p1[1]);a=max3f(a,p1[2],p1[3]);
  #pragma unroll
  for(int r=4;r<16;r+=4){a=max3f(a,p0[r],p0[r+1]);b=max3f(b,p0[r+2],p0[r+3]);a=max3f(a,p1[r],p1[r+1]);b=max3f(b,p1[r+2],p1[r+3]);}
  const float m=max2f(a,b);
  auto rr=__builtin_amdgcn_permlane32_swap(__float_as_uint(m),__float_as_uint(m),false,false);
  return max2f(__uint_as_float(rr[0]),__uint_as_float(rr[1]));
}
__device__ __forceinline__ void pv(f32x16*o,int vb,bf16x8 pa0,bf16x8 pa1,bf16x8 pa2,bf16x8 pa3){
  #pragma unroll
  for(int d0=0;d0<2;++d0){s16x4 lo[4],hi[4];
    #pragma unroll
    for(int ks=0;ks<4;++ks){
      asm volatile("ds_read_b64_tr_b16 %0,%1 offset:%c2":"=&v"(lo[ks]):"v"(vb),"i"(d0*4096+ks*1024):"memory");
      asm volatile("ds_read_b64_tr_b16 %0,%1 offset:%c2":"=&v"(hi[ks]):"v"(vb),"i"(d0*4096+ks*1024+512):"memory");}
    asm volatile("s_waitcnt lgkmcnt(0)":::"memory");SBAR();
    #define PK(k) (bf16x8){lo[k][0],lo[k][1],lo[k][2],lo[k][3],hi[k][0],hi[k][1],hi[k][2],hi[k][3]}
    o[d0]=__builtin_amdgcn_mfma_f32_32x32x16_bf16(pa0,PK(0),o[d0],0,0,0);
    o[d0]=__builtin_amdgcn_mfma_f32_32x32x16_bf16(pa1,PK(1),o[d0],0,0,0);
    o[d0]=__builtin_amdgcn_mfma_f32_32x32x16_bf16(pa2,PK(2),o[d0],0,0,0);
    o[d0]=__builtin_amdgcn_mfma_f32_32x32x16_bf16(pa3,PK(3),o[d0],0,0,0);
    #undef PK
  }
}

#ifndef ATTN_STORE16
#define ATTN_STORE16(p,v) (*(u32x4*)(p)=(v))
#endif
template<int THRL> __device__ __forceinline__ void attn_unit(int b,int h,int qb,const bf16*Q,const bf16*__restrict__ K,const bf16*__restrict__ V,bf16*O,const float*ksum,const float*biasl2,char*shm){
  const int tid=threadIdx.x,lane=tid&63,r32=lane&31,hi=lane>>5; const int wid=__builtin_amdgcn_readfirstlane(tid>>6);
  const long rowbase=(long)b*SEQ; const int q0=qb*QB;
  const bf16*Qw=Q+(rowbase+q0+wid*QBLK)*DM+h*D;
  const bf16*Kh=K+rowbase*DM+h*D,*Vh=V+rowbase*DM+h*D;
  const unsigned lds0=(unsigned)(uintptr_t)shm;
  float*wsf=(float*)(shm+LDS_WS)+wid*64;
  const bf16*ksrc=Kh+(long)lane*DM+wid*8;
  const bf16*vsrc=Vh+(long)(16*(wid&3)+(lane>>2))*DM+(wid>>2)*32+(lane&3)*8;
  const unsigned kdst=lds0+LDS_K+wid*1024, vdst=lds0+LDS_V+wid*1024;
  #define KT(t) (((t)<4)?(NT-4+(t)):((t)-4))
  #define DMA_K(t,slot) glds16(ksrc+(long)KT(t)*KVBLK*DM,(unsigned)__builtin_amdgcn_readfirstlane(kdst+(slot)))
  #define DMA_V(t,slot) glds16(vsrc+(long)KT(t)*KVBLK*DM,(unsigned)__builtin_amdgcn_readfirstlane(vdst+(slot)))
  const int vb0=(int)(lds0+LDS_V)+((lane>>4)&1)*32+(lane&3)*8+(4*hi+((lane&15)>>2))*64;
  const char*Kbase=shm+LDS_K; bf16x8 kf[8];
  const lds_cptr shm3=(lds_cptr)shm; const lds_cptr kp0=shm3+LDS_K+hi*1024+r32*16; const lds_cptr vp0=shm3+LDS_V+((lane>>4)&1)*32+(lane&3)*8+(4*hi+((lane&15)>>2))*64;
  const int NT=(q0+QB)/KVBLK;
  { typedef __attribute__((address_space(3))) float* lds_fptr; const lds_fptr ext=(lds_fptr)((__attribute__((address_space(3))) char*)shm+LDS_LUT); const lds_fptr kms=(lds_fptr)((__attribute__((address_space(3))) char*)shm+LDS_KMS); const float*bh=biasl2+h*128;
    for(int i=tid;i<1024;i+=512){const int d=i-256; ext[i]=d<0?-INFINITY:bh[d<127?d:127];}
    kms[tid]=ksum[(long)(b*8+(tid>>6))*512+h*64+(tid&63)]; }
  const float bfar=biasl2[h*128+127];
  DMA_K(0,0);DMA_V(0,0);DMA_K(1,SLOTB);
  bf16x8 qr[4];
  #pragma unroll
  for(int d0=0;d0<4;++d0)qr[d0]=*reinterpret_cast<const bf16x8*>(&Qw[(long)r32*DM+d0*16+hi*8]);
  float mhat=0.f,l_reg=0.f;f32x16 o[2];o[0]=f32x16{};o[1]=f32x16{};
  const int qrel=wid*QBLK+r32;
  unsigned selmask=0u;
  const __attribute__((address_space(3))) float* lut3=(const __attribute__((address_space(3))) float*)(shm3+LDS_LUT);
  #define OFFR(r) (((r)&3)+8*((r)>>2))
  #define CMASK(P0,P1,t) do{ const int t_=(t); \
    if(t_>=4&&t_<NT-4){ const float fa_=(((selmask>>(((t_-4)>>2)&7))&1u)?bfar:-INFINITY)-mhat; \
      _Pragma("unroll") for(int r=0;r<16;++r){P0[r]+=fa_;P1[r]+=fa_;} } \
    else{ int bi_; if(t_<4)bi_=256+qrel-64*t_-4*hi-59; else bi_=((selmask>>(qb-1))&1u)?(512+qrel-64*(t_-(NT-4))-4*hi-59):0; \
      const __attribute__((address_space(3))) float* lp_=lut3+bi_; \
      _Pragma("unroll") for(int r=0;r<16;++r){P0[r]+=lp_[59-OFFR(r)];P1[r]+=lp_[27-OFFR(r)];} \
      _Pragma("unroll") for(int r=0;r<16;++r){P0[r]-=mhat;P1[r]-=mhat;} } }while(0)
  bool resc=false;
  #define START(P0,P1) do{ const float rm=rowmax(P0,P1); resc=false; \
    { const float dl=rm; mhat=fadd_s(mhat,dl); \
      _Pragma("unroll") for(int r=0;r<16;++r){P0[r]=fsub_s(P0[r],dl);P1[r]=fsub_s(P1[r],dl);} \
      } \
    _Pragma("unroll") for(int r=0;r<16;++r)P0[r]=__builtin_amdgcn_exp2f(P0[r]); }while(0)
  #define RESC() do{ if(resc){ asm volatile("s_waitcnt lgkmcnt(0)":::"memory"); \
      _Pragma("unroll") for(int d_=0;d_<2;++d_) _Pragma("unroll") for(int r=0;r<16;++r)o[d_][r]*=wsf[crow(r,hi)]; } }while(0)
  f32x16 pA0,pA1,pB0,pB1;
  int sl_prev=0,sl_cur=0,sl_next=SLOTB;
  #define ROT() do{sl_prev=sl_cur;sl_cur=sl_next;sl_next=(sl_next==(NSLOT-1)*SLOTB)?0:sl_next+SLOTB;}while(0)
  DMA_K(2,2*SLOTB);
  WAIT_BAR(3);
  { const __attribute__((address_space(3))) float* kms3=(const __attribute__((address_space(3))) float*)(shm3+LDS_KMS);
    float g[8];
    _Pragma("unroll") for(int j=0;j<8;++j){ float a=0.f;
      if(j<qb){
        _Pragma("unroll") for(int d0=0;d0<4;++d0){ const __attribute__((address_space(3))) float* kp_=kms3+j*64+16*d0+8*hi;
          _Pragma("unroll") for(int e=0;e<8;++e) a+=__builtin_bit_cast(float,((unsigned)(unsigned short)qr[d0][e])<<16)*kp_[e]; }
        a+=__shfl_xor(a,32); }
      g[j]=a; }
    if(qb<=3) selmask=(1u<<qb)-1u;
    else{ _Pragma("unroll") for(int rr=0;rr<3;++rr){ int best=-1; float bv=-INFINITY;
        _Pragma("unroll") for(int j=0;j<8;++j){ const bool ok=(j<qb)&&!((selmask>>j)&1u)&&(g[j]>bv); if(ok){bv=g[j];best=j;} }
        if(best>=0)selmask|=1u<<best; } } }
  qkt(pA0,pA1,Kbase,qr,f32x16{},r32,hi);asm volatile("s_nop 15\n\ts_nop 7":"+v"(pA0),"+v"(pA1));CMASK(pA0,pA1,0);
  START(pA0,pA1);
  _Pragma("unroll") for(int r=0;r<16;++r)pA1[r]=__builtin_amdgcn_exp2f(pA1[r]);
  WAIT_BAR(0);
  DMA_K(3,0);DMA_V(1,SLOTB);
  ROT();
  kload8(kf,kp0+sl_cur);
  WAIT_BAR(2);
  s16x4 vlo[8],vhi[8]; u32x4 pw0,pw1,pw2,pw3;
  #define PKW(P,B) cvtpk_s(P[B],P[B+1])
  #define PAF(k) __builtin_bit_cast(bf16x8,pw##k)
  #define VFR(i) (bf16x8){vlo[i][0],vlo[i][1],vlo[i][2],vlo[i][3],vhi[i][0],vhi[i][1],vhi[i][2],vhi[i][3]}
  #define PIN(x) asm volatile("":"+v"(x))
  #define MX3(a,b,c) __builtin_fmaxf(__builtin_fmaxf((a),(b)),(c))
  #define GAPA(MF,A0,A1,A2,A3,W0,W1,PW) do{ MF; sacc+=A0; sacc+=A1; sacc+=A2; sacc+=A3; PIN(sacc); W0; W1; PIN(PW); SBAR(); }while(0)
  #define EX(v) __builtin_amdgcn_exp2f(v)
  #define GAPB(MF,X,B) do{ MF; X[B]=EX(X[B]); X[B+1]=EX(X[B+1]); X[B+2]=EX(X[B+2]); X[B+3]=EX(X[B+3]); PIN(X); SBAR(); }while(0)
  #define VRD(i) do{ vlo[i]=vtr(vp_+(((i)>>2)*4096+((i)&3)*1024)); vhi[i]=vtr(vp_+(((i)>>2)*4096+((i)&3)*1024+512)); }while(0)
  #define KRD(G,j) do{ if(G){ kload2(kf,kp0+sl_next,j); SBAR(); } }while(0)
  #define STEP(C0,C1,P0,P1,t,GK,GV,GL) do{ SBAR(); \
    const lds_cptr vp_=vp0+sl_prev; \
    VRD(0); SBAR(); float sacc=(P0[0]+P0[1]); \
    GAPA(C0=__builtin_amdgcn_mfma_f32_32x32x16_bf16(kf[0],qr[0],f32x16{},0,0,0), P0[2],P0[3],P0[4],P0[5],     pw0[0]=PKW(P0,0), pw0[1]=PKW(P0,2), pw0); \
    VRD(4); SBAR(); GAPA(C1=__builtin_amdgcn_mfma_f32_32x32x16_bf16(kf[1],qr[0],f32x16{},0,0,0), P0[6],P0[7],P0[8],P0[9],     pw0[2]=PKW(P0,4), pw0[3]=PKW(P0,6), pw0); \
    VRD(1); SBAR(); GAPA(C0=__builtin_amdgcn_mfma_f32_32x32x16_bf16(kf[2],qr[1],C0,0,0,0),   P0[10],P0[11],P0[12],P0[13], pw1[0]=PKW(P0,8), pw1[1]=PKW(P0,10), pw1); \
    VRD(5); SBAR(); GAPA(C1=__builtin_amdgcn_mfma_f32_32x32x16_bf16(kf[3],qr[1],C1,0,0,0),   P0[14],P0[15],P1[0],P1[1],   pw1[2]=PKW(P0,12),pw1[3]=PKW(P0,14), pw1); \
    VRD(2); SBAR(); GAPA(C0=__builtin_amdgcn_mfma_f32_32x32x16_bf16(kf[4],qr[2],C0,0,0,0),   P1[2],P1[3],P1[4],P1[5],     pw2[0]=PKW(P1,0), pw2[1]=PKW(P1,2), pw2); \
    VRD(6); SBAR(); GAPA(C1=__builtin_amdgcn_mfma_f32_32x32x16_bf16(kf[5],qr[2],C1,0,0,0),   P1[6],P1[7],P1[8],P1[9],     pw2[2]=PKW(P1,4), pw2[3]=PKW(P1,6), pw2); \
    VRD(3); SBAR(); GAPA(C0=__builtin_amdgcn_mfma_f32_32x32x16_bf16(kf[6],qr[3],C0,0,0,0),   P1[10],P1[11],P1[12],P1[13], pw3[0]=PKW(P1,8), pw3[1]=PKW(P1,10), pw3); \
    VRD(7); SBAR(); GAPA(C1=__builtin_amdgcn_mfma_f32_32x32x16_bf16(kf[7],qr[3],C1,0,0,0),   P1[14],P1[15],0.f,0.f,       pw3[2]=PKW(P1,12),pw3[3]=PKW(P1,14), pw3); \
    l_reg+=sacc; \
    if(GK){DMA_K((t)+3,sl_cur);} if(GV){DMA_V((t)+1,sl_next);} \
    CMASK(C0,C1,t); \
    { float a=MX3(C0[0],C0[1],C1[0]),b=MX3(C0[2],C0[3],C1[1]); a=MX3(a,C1[2],C1[3]); \
      _Pragma("unroll") for(int r=4;r<16;r+=4){a=MX3(a,C0[r],C0[r+1]);b=MX3(b,C0[r+2],C0[r+3]);a=MX3(a,C1[r],C1[r+1]);b=MX3(b,C1[r+2],C1[r+3]);} \
      float rm=__builtin_fmaxf(a,b); { auto rr=__builtin_amdgcn_permlane32_swap(__float_as_uint(rm),__float_as_uint(rm),false,false); rm=__builtin_fmaxf(__uint_as_float(rr[0]),__uint_as_float(rr[1])); } \
      resc=false; \
      if(__builtin_expect(__any(rm>(float)THRL),0)){ const float dl=__builtin_fmaxf(rm,0.f); mhat+=dl; \
        _Pragma("unroll") for(int r=0;r<16;++r){C0[r]-=dl;C1[r]-=dl;} \
        const float f=__builtin_amdgcn_exp2f(-dl); l_reg*=f; if(hi==0)wsf[r32]=f; resc=true; } } \
    SBAR(); \
    GAPB(o[0]=__builtin_amdgcn_mfma_f32_32x32x16_bf16(PAF(0),VFR(0),o[0],0,0,0), C0,0); \
    GAPB(o[1]=__builtin_amdgcn_mfma_f32_32x32x16_bf16(PAF(0),VFR(4),o[1],0,0,0), C0,4); \
    KRD(GL,0); GAPB(o[0]=__builtin_amdgcn_mfma_f32_32x32x16_bf16(PAF(1),VFR(1),o[0],0,0,0), C0,8); \
    KRD(GL,1); GAPB(o[1]=__builtin_amdgcn_mfma_f32_32x32x16_bf16(PAF(1),VFR(5),o[1],0,0,0), C0,12); \
    KRD(GL,2); GAPB(o[0]=__builtin_amdgcn_mfma_f32_32x32x16_bf16(PAF(2),VFR(2),o[0],0,0,0), C1,0); \
    KRD(GL,3); GAPB(o[1]=__builtin_amdgcn_mfma_f32_32x32x16_bf16(PAF(2),VFR(6),o[1],0,0,0), C1,4); \
    GAPB(o[0]=__builtin_amdgcn_mfma_f32_32x32x16_bf16(PAF(3),VFR(3),o[0],0,0,0), C1,8); \
    GAPB(o[1]=__builtin_amdgcn_mfma_f32_32x32x16_bf16(PAF(3),VFR(7),o[1],0,0,0), C1,12); \
    }while(0)
  int t=1;
  for(;t+5<NT;t+=2){
    STEP(pB0,pB1,pA0,pA1,t,true,true,true);     WAIT_BAR(2); RESC(); ROT();
    STEP(pA0,pA1,pB0,pB1,t+1,true,true,true);   WAIT_BAR(2); RESC(); ROT();
  }
  #define ENDW(tt) do{ if((tt)+3<NT){WAIT_BAR(2);} else if((tt)+2<NT){WAIT_BAR(1);} else {WAIT_BAR(0);} }while(0)
  for(;t+1<NT;t+=2){
    STEP(pB0,pB1,pA0,pA1,t,(t+3<NT),(t+1<NT),(t+1<NT));       ENDW(t);   RESC(); ROT();
    STEP(pA0,pA1,pB0,pB1,t+1,(t+4<NT),(t+2<NT),(t+2<NT));     ENDW(t+1); RESC(); ROT();
  }
  STEP(pB0,pB1,pA0,pA1,NT-1,false,false,false); RESC();
  { float sacc=pB0[0]+pB0[1]; _Pragma("unroll") for(int r=2;r<16;++r)sacc+=pB0[r]; _Pragma("unroll") for(int r=0;r<16;++r)sacc+=pB1[r]; l_reg+=sacc;
    pw0=(u32x4){PKW(pB0,0),PKW(pB0,2),PKW(pB0,4),PKW(pB0,6)};pw1=(u32x4){PKW(pB0,8),PKW(pB0,10),PKW(pB0,12),PKW(pB0,14)};pw2=(u32x4){PKW(pB1,0),PKW(pB1,2),PKW(pB1,4),PKW(pB1,6)};pw3=(u32x4){PKW(pB1,8),PKW(pB1,10),PKW(pB1,12),PKW(pB1,14)};
    SBAR(); pv(o,vb0+sl_cur,PAF(0),PAF(1),PAF(2),PAF(3)); }
  #undef PKW
  #undef PAF
  #undef VFR
  #undef PIN
  #undef MX3
  #undef GAPA
  #undef GAPB
  #undef EX
  #undef VRD
  #undef KRD
  #undef STEP
  #undef ENDW
  {auto rr=__builtin_amdgcn_permlane32_swap(__float_as_uint(l_reg),__float_as_uint(l_reg),false,false);l_reg=__uint_as_float(rr[0])+__uint_as_float(rr[1]);}
  if(hi==0)wsf[32+r32]=l_reg;asm volatile("s_waitcnt lgkmcnt(0)":::"memory");
  float rli[16];
  #pragma unroll
  for(int r=0;r<16;++r)rli[r]=__builtin_amdgcn_rcpf(wsf[32+crow(r,hi)]);
  bf16*Ow=O+(rowbase+q0+wid*QBLK)*OPITCH+h*D;
  { bf16*stg=(bf16*)(shm+LDS_OST)+wid*2048;
    #pragma unroll
    for(int r=0;r<16;++r){const int orow=crow(r,hi);
      #pragma unroll
      for(int d0=0;d0<2;++d0)stg[orow*64+d0*32+r32]=__float2bfloat16(o[d0][r]*rli[r]);}
    asm volatile("s_waitcnt lgkmcnt(0)":::"memory");
    #pragma unroll
    for(int i=0;i<4;++i){const int row=i*8+(lane>>3),ch=lane&7; const u32x4 v=*(const u32x4*)(stg+row*64+ch*8); ATTN_STORE16(Ow+(long)row*OPITCH+ch*8,v);} }
  asm volatile("s_waitcnt lgkmcnt(0)\n\ts_barrier":::"memory");
  #undef DMA_K
  #undef DMA_V
  #undef KT
  #undef OFFR
  #undef CMASK
  #undef START
  #undef RESC
  #undef ROT
}
constexpr int ATTN_LDS_BYTES=LDS_BYTES;
struct AttnTensors { const bf16* Q; const bf16* K; const bf16* V; bf16* O; const float* ksum; const float* biasl2; };
struct AttnUnit { int bh; int qb; };
struct StaticOrder {
  int vcu;
  __device__ __forceinline__ explicit StaticOrder(int grid,int block):vcu((block%8)*(grid/8)+block/8){}
  __device__ __forceinline__ bool next(int i,AttnUnit&u)const{ if(i>=4||vcu>=256)return false; const int p=vcu&1; u.bh=vcu>>1; u.qb=(i==0)?7-p:(i==1)?p:(i==2)?4+p:3-p; return true; }
  __device__ __forceinline__ void a_ready(const AttnUnit&)const{}
  __device__ __forceinline__ void done(const AttnUnit&)const{}
};
template<class Sched,int THRL=8> __device__ __forceinline__ void attn_phase(char*lds,const AttnTensors&T,const Sched&S){
  AttnUnit u;
  for(int i=0;S.next(i,u);++i){ S.a_ready(u); attn_unit<THRL>(u.bh/NHEAD,u.bh%NHEAD,u.qb,T.Q,T.K,T.V,T.O,T.ksum,T.biasl2,lds); S.done(u); }
}
#undef SBAR
#undef WAIT_BAR
}
namespace attn_body {
namespace xa {
constexpr int XP=1024, XSLOT=32768, X_RING=0, X_OST=2*XSLOT, X_WS=X_OST+NW*4096, X_LDS_BYTES=X_WS+NW*256;
#define XWAITBAR(N) asm volatile("s_waitcnt vmcnt(" #N ") lgkmcnt(0)\n\ts_barrier":::"memory")
#define XBAR() asm volatile("s_waitcnt lgkmcnt(0)\n\ts_barrier":::"memory")
__device__ __forceinline__ void xattn_unit(int b,int h,int qb,const bf16*Q,const bf16*__restrict__ K,const bf16*__restrict__ V,bf16*O,char*shm){
  const int tid=threadIdx.x,lane=tid&63,r32=lane&31,hi=lane>>5; const int wid=__builtin_amdgcn_readfirstlane(tid>>6);
  const long qrow0=(long)b*2048+qb*256+wid*32; const long krow0=(long)b*256;
  const bf16*Qw=Q+qrow0*XP+h*256;
  const bf16*Kh=K+krow0*XP+h*256,*Vh=V+krow0*XP+h*256;
  const unsigned lds0=(unsigned)(uintptr_t)shm;
  const bf16*ksrc=Kh+(long)lane*XP+wid*8;
  const bf16*vsrc=Vh+(long)(16*(wid&3)+(lane>>2))*XP+(wid>>2)*32+(lane&3)*8;
  const unsigned kdst=lds0+X_RING+wid*1024;
  #define XDMA_K(t,slot) do{ _Pragma("unroll") for(int g_=0;g_<4;++g_) glds16(ksrc+(long)(t)*64*XP+g_*64,(unsigned)__builtin_amdgcn_readfirstlane(kdst+(slot)*XSLOT+g_*8192)); }while(0)
  #define XDMA_V(t,slot) do{ _Pragma("unroll") for(int g_=0;g_<4;++g_) glds16(vsrc+(long)(t)*64*XP+g_*64,(unsigned)__builtin_amdgcn_readfirstlane(kdst+(slot)*XSLOT+g_*8192)); }while(0)
  const lds_cptr shm3=(lds_cptr)shm;
  const lds_cptr kp0=shm3+X_RING+hi*1024+r32*16;
  const lds_cptr vp0=shm3+X_RING+((lane>>4)&1)*32+(lane&3)*8+(4*hi+((lane&15)>>2))*64;
  bf16x8 qr[16];
  #pragma unroll
  for(int i=0;i<16;++i)qr[i]=*reinterpret_cast<const bf16x8*>(&Qw[(long)r32*XP+i*16+hi*8]);
  asm volatile("":::"memory");
  XDMA_K(0,0); XDMA_K(1,1);
  f32x16 s[8];
  #define XQK(t,slot) do{ const lds_cptr kb_=kp0+(slot)*XSLOT; f32x16 c0_=f32x16{},c1_=f32x16{}; \
    _Pragma("unroll") for(int g_=0;g_<4;++g_) _Pragma("unroll") for(int d0=0;d0<4;++d0){ \
      const bf16x8 b0_=*(const __attribute__((address_space(3))) bf16x8*)(kb_+g_*8192+d0*2048); \
      const bf16x8 b1_=*(const __attribute__((address_space(3))) bf16x8*)(kb_+g_*8192+d0*2048+512); \
      c0_=__builtin_amdgcn_mfma_f32_32x32x16_bf16(b0_,qr[g_*4+d0],c0_,0,0,0); c1_=__builtin_amdgcn_mfma_f32_32x32x16_bf16(b1_,qr[g_*4+d0],c1_,0,0,0);} \
    s[2*(t)]=c0_; s[2*(t)+1]=c1_; }while(0)
  XWAITBAR(4); XQK(0,0); XBAR(); XDMA_K(2,0);
  XWAITBAR(4); XQK(1,1); XBAR(); XDMA_K(3,1);
  XWAITBAR(4); XQK(2,0); XBAR(); XDMA_V(0,0);
  XWAITBAR(4); XQK(3,1); XBAR(); XDMA_V(1,1);
  float mx=s[0][0];
  #pragma unroll
  for(int t=0;t<8;++t)
    #pragma unroll
    for(int r=0;r<16;++r)mx=__builtin_fmaxf(mx,s[t][r]);
  { auto rr=__builtin_amdgcn_permlane32_swap(__float_as_uint(mx),__float_as_uint(mx),false,false); mx=__builtin_fmaxf(__uint_as_float(rr[0]),__uint_as_float(rr[1])); }
  float l=0.f;
  #pragma unroll
  for(int t=0;t<8;++t)
    #pragma unroll
    for(int r=0;r<16;++r){ s[t][r]=__builtin_amdgcn_exp2f(s[t][r]-mx); l+=s[t][r]; }
  { auto rr=__builtin_amdgcn_permlane32_swap(__float_as_uint(l),__float_as_uint(l),false,false); l=__uint_as_float(rr[0])+__uint_as_float(rr[1]); }
  u32x4 pw[16];
  #pragma unroll
  for(int t=0;t<4;++t){
    pw[4*t+0]=(u32x4){cvtpk_s(s[2*t][0],s[2*t][1]),cvtpk_s(s[2*t][2],s[2*t][3]),cvtpk_s(s[2*t][4],s[2*t][5]),cvtpk_s(s[2*t][6],s[2*t][7])};
    pw[4*t+1]=(u32x4){cvtpk_s(s[2*t][8],s[2*t][9]),cvtpk_s(s[2*t][10],s[2*t][11]),cvtpk_s(s[2*t][12],s[2*t][13]),cvtpk_s(s[2*t][14],s[2*t][15])};
    pw[4*t+2]=(u32x4){cvtpk_s(s[2*t+1][0],s[2*t+1][1]),cvtpk_s(s[2*t+1][2],s[2*t+1][3]),cvtpk_s(s[2*t+1][4],s[2*t+1][5]),cvtpk_s(s[2*t+1][6],s[2*t+1][7])};
    pw[4*t+3]=(u32x4){cvtpk_s(s[2*t+1][8],s[2*t+1][9]),cvtpk_s(s[2*t+1][10],s[2*t+1][11]),cvtpk_s(s[2*t+1][12],s[2*t+1][13]),cvtpk_s(s[2*t+1][14],s[2*t+1][15])}; }
  f32x16 o[8];
  #pragma unroll
  for(int i=0;i<8;++i)o[i]=f32x16{};
  #define XPV(t,slot) do{ const lds_cptr vb_=vp0+(slot)*XSLOT; \
    _Pragma("unroll") for(int g_=0;g_<4;++g_) _Pragma("unroll") for(int d0=0;d0<2;++d0){ s16x4 lo_[4],hi_[4]; \
      _Pragma("unroll") for(int ks=0;ks<4;++ks){ lo_[ks]=vtr(vb_+g_*8192+d0*4096+ks*1024); hi_[ks]=vtr(vb_+g_*8192+d0*4096+ks*1024+512); } \
      _Pragma("unroll") for(int ks=0;ks<4;++ks) o[g_*2+d0]=__builtin_amdgcn_mfma_f32_32x32x16_bf16(__builtin_bit_cast(bf16x8,pw[4*(t)+ks]), \
          (bf16x8){lo_[ks][0],lo_[ks][1],lo_[ks][2],lo_[ks][3],hi_[ks][0],hi_[ks][1],hi_[ks][2],hi_[ks][3]},o[g_*2+d0],0,0,0); } }while(0)
  XWAITBAR(4); XPV(0,0); XBAR(); XDMA_V(2,0);
  XWAITBAR(4); XPV(1,1); XBAR(); XDMA_V(3,1);
  XWAITBAR(4); XPV(2,0); XBAR();
  XWAITBAR(0); XPV(3,1); XBAR();
  float*wsf=(float*)(shm+X_WS)+wid*64;
  if(hi==0)wsf[r32]=l; asm volatile("s_waitcnt lgkmcnt(0)":::"memory");
  float rli[16];
  #pragma unroll
  for(int r=0;r<16;++r)rli[r]=__builtin_amdgcn_rcpf(wsf[crow(r,hi)]);
  bf16*Ow=O+qrow0*XP+h*256;
  bf16*stg=(bf16*)(shm+X_OST)+wid*2048;
  #pragma unroll
  for(int g=0;g<4;++g){
    #pragma unroll
    for(int r=0;r<16;++r){const int orow=crow(r,hi);
      #pragma unroll
      for(int d0=0;d0<2;++d0)stg[orow*64+d0*32+r32]=__float2bfloat16(o[g*2+d0][r]*rli[r]);}
    asm volatile("s_waitcnt lgkmcnt(0)":::"memory");
    #pragma unroll
    for(int i=0;i<4;++i){const int row=i*8+(lane>>3),ch=lane&7; const u32x4 v=*(const u32x4*)(stg+row*64+ch*8); *(u32x4*)(Ow+(long)row*XP+g*64+ch*8)=v;}
    asm volatile("s_waitcnt lgkmcnt(0)":::"memory");
  }
  asm volatile("s_waitcnt vmcnt(0) lgkmcnt(0)\n\ts_barrier":::"memory");
  #undef XDMA_K
  #undef XDMA_V
  #undef XQK
  #undef XPV
}
__device__ __forceinline__ void xattn_phase(char*lds,const bf16*Q,const bf16*K,const bf16*V,bf16*O,int grid,int block){
  const int vcu=(block%8)*(grid/8)+block/8; if(vcu>=256)return;
  const int bh=vcu>>2;
  for(int i=0;i<2;++i) xattn_unit(bh>>2,bh&3,2*(vcu&3)+i,Q,K,V,O,lds);
}
#undef XWAITBAR
#undef XBAR
}
}
namespace attn_body {
namespace gla {
typedef __attribute__((address_space(3))) char* lptr;
typedef __attribute__((address_space(3))) float* lfptr;
typedef float f32x4v __attribute__((ext_vector_type(4)));
typedef float f32x2v __attribute__((ext_vector_type(2)));
typedef unsigned u32x2v __attribute__((ext_vector_type(2)));
constexpr int GP=144;
constexpr int L_WG=0, L_BG=16384, L_QE=17408, L_KE=L_QE+64*GP, L_KLT=L_KE+64*GP, L_V=49152, L_P1_BYTES=L_V+16384;
constexpr int OBP=132;
__device__ __forceinline__ float bfv(short s){return __builtin_bit_cast(float,((unsigned)(unsigned short)s)<<16);}
__device__ __forceinline__ unsigned short f2b(float f){ return (unsigned short)(cvtpk_s(f,0.f)&0xffffu); }

__device__ __forceinline__ void gla_pass1(char*shm,int grid,int block,const bf16*QG_,const bf16*KG_,const bf16*VG_,const float*GLR,const float*wgu,const float*bgate,
                                          bf16*QE_,float*DEC,float*GU,float*GOI){
  const unsigned short*QG=(const unsigned short*)QG_; const unsigned short*KG=(const unsigned short*)KG_; const unsigned short*VG=(const unsigned short*)VG_; unsigned short*QE=(unsigned short*)QE_;
  const int tid=threadIdx.x,lane=tid&63,r32=lane&31,h=lane>>5; const int w=__builtin_amdgcn_readfirstlane(tid>>6);
  const lptr sh=(lptr)shm;
  { const lfptr wl=(lfptr)(sh+L_WG); const lfptr bl=(lfptr)(sh+L_BG);
    for(int i=tid;i<16*256;i+=512) wl[i]=wgu[i];
    if(tid<256) bl[tid]=bgate[tid]; }
  const int hh=w&1,vq=w>>1;
  const int c16=(lane>>4)&1,qq=(lane&15)>>2,pp=lane&3;
  const int vcol=(vq>>1)*8192+(vq&1)*4096+(16*c16+4*pp)*2;
  const int vnat=vcol+(8*h+qq)*64, vper=vcol+(4*h+qq)*64;
  for(int it=0;it<8;++it){
    const int uid=it*grid+block; if(uid>=2048)break;
    const int chain=uid>>5,c=uid&31,b=chain>>2,hg=chain&3; const long r0=(long)b*2048+c*64;
    asm volatile("s_waitcnt lgkmcnt(0)\n\ts_barrier":::"memory");
    { const long row=r0+lane;
      f32x4v gl4[4];
      #pragma unroll
      for(int i=0;i<4;++i)gl4[i]=*(const f32x4v*)(GLR+row*16+4*i);
      const bf16x8 q8=*(const bf16x8*)(QG+row*256+hg*64+8*w), k8=*(const bf16x8*)(KG+row*256+hg*64+8*w);
      #pragma unroll
      for(int i=0;i<2;++i){ const int e=tid+512*i, vr=e>>4, d8=(e&15)*8;
        const u32x4 vv=*(const u32x4*)(VG+(r0+vr)*512+hg*128+d8);
        *(__attribute__((address_space(3))) u32x4*)(sh+L_V+(d8>>6)*8192+((d8>>5)&1)*4096+(vr>>4)*1024+(vr&15)*64+(d8&31)*2)=vv; }
      float z[8];
      { const lfptr bl=(lfptr)(sh+L_BG);
        #pragma unroll
        for(int j=0;j<8;++j)z[j]=bl[hg*64+8*w+j]; }
      #pragma unroll
      for(int r=0;r<16;++r){ const float gv=gl4[r>>2][r&3]; const lfptr wl=(lfptr)(sh+L_WG)+r*256+hg*64+8*w;
        const f32x4v w0=*(__attribute__((address_space(3))) f32x4v*)wl, w1=*(__attribute__((address_space(3))) f32x4v*)(wl+4);
        z[0]+=gv*w0[0];z[1]+=gv*w0[1];z[2]+=gv*w0[2];z[3]+=gv*w0[3];z[4]+=gv*w1[0];z[5]+=gv*w1[1];z[6]+=gv*w1[2];z[7]+=gv*w1[3]; }
      float bc[8],bl_[8];
      #pragma unroll
      for(int j=0;j<8;++j){ const float zz=z[j]; float v=(fminf(zz,0.f)-__logf(1.f+__expf(-fabsf(zz))))*0.0625f;
        #pragma unroll
        for(int d=1;d<64;d<<=1){ const float u=__shfl_up(v,d); if(lane>=d)v+=u; }
        bc[j]=v; bl_[j]=__shfl(v,63); }
      unsigned short qe[8],ke[8];
      __attribute__((address_space(3))) unsigned short* kltp=(__attribute__((address_space(3))) unsigned short*)(sh+L_KLT);
      #pragma unroll
      for(int j=0;j<8;++j){ const float kv=bfv(k8[j]);
        qe[j]=f2b(bfv(q8[j])*__expf(bc[j])); ke[j]=f2b(kv*__expf(-bc[j]));
        kltp[(8*w+j)*(GP/2)+lane]=f2b(kv*__expf(bl_[j]-bc[j])); }
      const u32x4 qv=(u32x4){(unsigned)qe[0]|((unsigned)qe[1]<<16),(unsigned)qe[2]|((unsigned)qe[3]<<16),(unsigned)qe[4]|((unsigned)qe[5]<<16),(unsigned)qe[6]|((unsigned)qe[7]<<16)};
      const u32x4 kvv=(u32x4){(unsigned)ke[0]|((unsigned)ke[1]<<16),(unsigned)ke[2]|((unsigned)ke[3]<<16),(unsigned)ke[4]|((unsigned)ke[5]<<16),(unsigned)ke[6]|((unsigned)ke[7]<<16)};
      *(__attribute__((address_space(3))) u32x4*)(sh+L_QE+lane*GP+16*w)=qv;
      *(__attribute__((address_space(3))) u32x4*)(sh+L_KE+lane*GP+16*w)=kvv;
      *(u32x4*)(QE+row*256+hg*64+8*w)=qv;
      if(lane==0){ float*dp=DEC+(long)uid*64+8*w;
        *(f32x4v*)dp=(f32x4v){__expf(bl_[0]),__expf(bl_[1]),__expf(bl_[2]),__expf(bl_[3])}; *(f32x4v*)(dp+4)=(f32x4v){__expf(bl_[4]),__expf(bl_[5]),__expf(bl_[6]),__expf(bl_[7])}; }
    }
    asm volatile("s_waitcnt lgkmcnt(0)\n\ts_barrier":::"memory");
    { const lds_cptr shc=(lds_cptr)shm;
      f32x16 u=f32x16{};
      #pragma unroll
      for(int s=0;s<4;++s){
        const bf16x8 a=*(const __attribute__((address_space(3))) bf16x8*)(shc+L_KLT+(32*hh+r32)*GP+(16*s+8*h)*2);
        const s16x4 lo=vtr(shc+L_V+vnat+s*1024), hi_=vtr(shc+L_V+vnat+s*1024+256);
        u=__builtin_amdgcn_mfma_f32_32x32x16_bf16(a,(bf16x8){lo[0],lo[1],lo[2],lo[3],hi_[0],hi_[1],hi_[2],hi_[3]},u,0,0,0); }
      f32x16 o=f32x16{};
      #pragma unroll
      for(int a=0;a<2;++a){ if(a<=hh){
        f32x16 at=f32x16{};
        #pragma unroll
        for(int s=0;s<4;++s){
          const bf16x8 ka=*(const __attribute__((address_space(3))) bf16x8*)(shc+L_KE+(32*a+r32)*GP+(16*s+8*h)*2);
          const bf16x8 qb=*(const __attribute__((address_space(3))) bf16x8*)(shc+L_QE+(32*hh+r32)*GP+(16*s+8*h)*2);
          at=__builtin_amdgcn_mfma_f32_32x32x16_bf16(ka,qb,at,0,0,0); }
        if(a==hh){
          #pragma unroll
          for(int r=0;r<16;++r) if(crow(r,h)>r32) at[r]=0.f; }
        const u32x4 p0=(u32x4){cvtpk_s(at[0],at[1]),cvtpk_s(at[2],at[3]),cvtpk_s(at[4],at[5]),cvtpk_s(at[6],at[7])};
        const u32x4 p1=(u32x4){cvtpk_s(at[8],at[9]),cvtpk_s(at[10],at[11]),cvtpk_s(at[12],at[13]),cvtpk_s(at[14],at[15])};
        { const s16x4 lo=vtr(shc+L_V+vper+(2*a)*1024), hi_=vtr(shc+L_V+vper+(2*a)*1024+512);
          o=__builtin_amdgcn_mfma_f32_32x32x16_bf16(__builtin_bit_cast(bf16x8,p0),(bf16x8){lo[0],lo[1],lo[2],lo[3],hi_[0],hi_[1],hi_[2],hi_[3]},o,0,0,0); }
        { const s16x4 lo=vtr(shc+L_V+vper+(2*a+1)*1024), hi_=vtr(shc+L_V+vper+(2*a+1)*1024+512);
          o=__builtin_amdgcn_mfma_f32_32x32x16_bf16(__builtin_bit_cast(bf16x8,p1),(bf16x8){lo[0],lo[1],lo[2],lo[3],hi_[0],hi_[1],hi_[2],hi_[3]},o,0,0,0); }
      } }
      float*up=GU+(long)uid*8192+(hh*4+vq)*1024+lane*4; float*op=GOI+(long)uid*8192+(hh*4+vq)*1024+lane*4;
      #pragma unroll
      for(int g=0;g<4;++g){ *(f32x4v*)(up+g*256)=(f32x4v){u[4*g],u[4*g+1],u[4*g+2],u[4*g+3]}; *(f32x4v*)(op+g*256)=(f32x4v){o[4*g],o[4*g+1],o[4*g+2],o[4*g+3]}; }
    }
  }
  asm volatile("s_waitcnt lgkmcnt(0)\n\ts_barrier":::"memory");
}

struct ChainLoad { u32x4 u0[4],u1[4],d0[4],d1[4],oi[4]; u32x2v qa[8]; };
__device__ __forceinline__ void gla_chain(char*shm,int chain,const bf16*QE_,const float*DEC,const float*GU,const float*GOI,const bf16*RG_,const float*gnorm,bf16*MIX_){
  const int tid=threadIdx.x,lane=tid&63,r32=lane&31,h=lane>>5; const int w=__builtin_amdgcn_readfirstlane(tid>>6);
  const int hh=w&1,vq=w>>1,b=chain>>2,hg=chain&3;
  const __amdgpu_buffer_rsrc_t rU=__builtin_amdgcn_make_buffer_rsrc((void*)(GU+(long)chain*32*8192),0,32*8192*4,0x00020000);
  const __amdgpu_buffer_rsrc_t rO=__builtin_amdgcn_make_buffer_rsrc((void*)(GOI+(long)chain*32*8192),0,32*8192*4,0x00020000);
  const __amdgpu_buffer_rsrc_t rD=__builtin_amdgcn_make_buffer_rsrc((void*)(DEC+(long)chain*32*64),0,32*64*4,0x00020000);
  const __amdgpu_buffer_rsrc_t rQ=__builtin_amdgcn_make_buffer_rsrc((void*)((const unsigned short*)QE_+(long)b*2048*256),0,2048*256*2,0x00020000);
  const __amdgpu_buffer_rsrc_t rR=__builtin_amdgcn_make_buffer_rsrc((void*)((const unsigned short*)RG_+(long)b*2048*512),0,2048*512*2,0x00020000);
  const __amdgpu_buffer_rsrc_t rM=__builtin_amdgcn_make_buffer_rsrc((void*)((unsigned short*)MIX_+(long)b*2048*1024),0,2048*1024*2,0x00020000);
  const int voU=(vq*1024+lane*4)*4, voO=((hh*4+vq)*1024+lane*4)*4, voD=16*h, voQ=((32*hh+r32)*256+hg*64+4*h)*2, voR=hg*256+lane*4, voM=(512+hg*128)*2+lane*4;
  const lfptr ob=(lfptr)((lptr)shm);
  f32x16 S0=f32x16{},S1=f32x16{};
  const float gn0=gnorm[2*lane],gn1=gnorm[2*lane+1];
  #define CH_LOAD(L,cc) do{ const int sU_=(cc)*32768, sD_=(cc)*256, sQ_=(cc)*32768; \
    _Pragma("unroll") for(int g=0;g<4;++g){ L.u0[g]=__builtin_amdgcn_raw_buffer_load_b128(rU,voU+g*1024,sU_,0); L.u1[g]=__builtin_amdgcn_raw_buffer_load_b128(rU,voU+g*1024,sU_+16384,0); \
      L.oi[g]=__builtin_amdgcn_raw_buffer_load_b128(rO,voO+g*1024,sU_,0); L.d0[g]=__builtin_amdgcn_raw_buffer_load_b128(rD,voD+32*g,sD_,0); L.d1[g]=__builtin_amdgcn_raw_buffer_load_b128(rD,voD+128+32*g,sD_,0); } \
    _Pragma("unroll") for(int k=0;k<4;++k){ L.qa[2*k]=__builtin_amdgcn_raw_buffer_load_b64(rQ,voQ+32*k,sQ_,0); L.qa[2*k+1]=__builtin_amdgcn_raw_buffer_load_b64(rQ,voQ+32*k+16,sQ_,0); } }while(0)
  ChainLoad A; CH_LOAD(A,0);
  #pragma unroll 1
  for(int c=0;c<32;++c){
    unsigned rgv[8];
    #pragma unroll
    for(int i=0;i<8;++i) rgv[i]=__builtin_amdgcn_raw_buffer_load_b32(rR,voR,(c*64+8*w+i)*1024,0);
    f32x16 o;
    #pragma unroll
    for(int g=0;g<4;++g){ const f32x4v t4=__builtin_bit_cast(f32x4v,A.oi[g]); o[4*g]=t4[0];o[4*g+1]=t4[1];o[4*g+2]=t4[2];o[4*g+3]=t4[3]; }
    #pragma unroll
    for(int k=0;k<4;++k){ const int dh=k>>1,s=k&1;
      u32x4 bw;
      if(dh==0) bw=(u32x4){cvtpk_s(S0[8*s],S0[8*s+1]),cvtpk_s(S0[8*s+2],S0[8*s+3]),cvtpk_s(S0[8*s+4],S0[8*s+5]),cvtpk_s(S0[8*s+6],S0[8*s+7])};
      else      bw=(u32x4){cvtpk_s(S1[8*s],S1[8*s+1]),cvtpk_s(S1[8*s+2],S1[8*s+3]),cvtpk_s(S1[8*s+4],S1[8*s+5]),cvtpk_s(S1[8*s+6],S1[8*s+7])};
      const u32x4 aw=(u32x4){A.qa[2*k][0],A.qa[2*k][1],A.qa[2*k+1][0],A.qa[2*k+1][1]};
      o=__builtin_amdgcn_mfma_f32_32x32x16_bf16(__builtin_bit_cast(bf16x8,aw),__builtin_bit_cast(bf16x8,bw),o,0,0,0); }
    #pragma unroll
    for(int g=0;g<4;++g){ const f32x4v d0=__builtin_bit_cast(f32x4v,A.d0[g]),d1=__builtin_bit_cast(f32x4v,A.d1[g]),u0=__builtin_bit_cast(f32x4v,A.u0[g]),u1=__builtin_bit_cast(f32x4v,A.u1[g]);
      #pragma unroll
      for(int e=0;e<4;++e){ S0[4*g+e]=S0[4*g+e]*d0[e]+u0[e]; S1[4*g+e]=S1[4*g+e]*d1[e]+u1[e]; } }
    if(c+1<32){ CH_LOAD(A,c+1); }
    const lfptr obc=ob+(c&1)*64*OBP;
    #pragma unroll
    for(int r=0;r<16;++r) obc[(32*hh+crow(r,h))*OBP+32*vq+r32]=o[r];
    asm volatile("s_waitcnt lgkmcnt(0)\n\ts_barrier":::"memory");
    #pragma unroll
    for(int i=0;i<8;++i){ const int t=8*w+i; const f32x2v vv=*(const __attribute__((address_space(3))) f32x2v*)(obc+t*OBP+2*lane); const float v0=vv[0],v1=vv[1];
      float ss=v0*v0+v1*v1;
      #pragma unroll
      for(int d=1;d<64;d<<=1)ss+=__shfl_xor(ss,d);
      const float rstd=__builtin_amdgcn_rsqf(ss*(1.f/128.f)+1e-6f);
      const float g0=__builtin_bit_cast(float,rgv[i]<<16),g1=__builtin_bit_cast(float,rgv[i]&0xffff0000u);
      const float y0=v0*rstd*gn0*(g0/(1.f+__expf(-g0))), y1=v1*rstd*gn1*(g1/(1.f+__expf(-g1)));
      __builtin_amdgcn_raw_buffer_store_b32(cvtpk_s(y0,y1),rM,voM,(c*64+t)*2048,0); }
  }
  #undef CH_LOAD
  asm volatile("s_waitcnt vmcnt(0) lgkmcnt(0)\n\ts_barrier":::"memory");
}
}
}
#define PG8_SP2 true
#define PG8_ALIGN true

constexpr int NWAVES = 8;
constexpr int BATCH = 16, SEQ = 2048, DM = 1024, M = BATCH * SEQ;
constexpr int MEMLEN = 256, MM = BATCH * MEMLEN;
constexpr int AH = 8, AHD = 64, AW = 512, NBLK = SEQ / 256;
constexpr int GH = 4, GHK = 64, GHV = 128, GKW = 256, GW = 512, GRANK = 16;
constexpr int XH = 4, XHD = 256;
constexpr int FF = 4096;
constexpr int NIN = 3328;
constexpr float EPS = 1e-6f;
constexpr float LOG2E = 1.4426950408889634f;
constexpr float C2A = 0.125f * LOG2E;
constexpr float C2X = 0.0625f * LOG2E;

constexpr size_t MiB = 1u << 20;
constexpr size_t WS_CTL = 0, CTL_ZERO_BYTES = 256 * 1024;
constexpr size_t WS_SSQ1 = 1 * MiB, WS_SSQ2 = WS_SSQ1 + 128 * 1024, WS_SSQ3 = WS_SSQ2 + 128 * 1024;
constexpr size_t WS_KSUM = WS_SSQ3 + 128 * 1024;
constexpr size_t WS_BIAS = WS_KSUM + 256 * 1024;
constexpr size_t WS_WIN = 2 * MiB, WS_WOUT = 9 * MiB, WS_WXQ = 11 * MiB, WS_WXKV = 13 * MiB, WS_WXO = 17 * MiB, WS_WUP = 19 * MiB, WS_WDN = 27 * MiB;
constexpr size_t WS_GLR = 36 * MiB;
constexpr size_t WS_MN = 38 * MiB, WS_KX = 46 * MiB, WS_VX = 54 * MiB;
constexpr size_t WS_HA = 64 * MiB;
constexpr size_t WS_MIX = 128 * MiB;
constexpr size_t WS_QA = 192 * MiB, WS_KA = 224 * MiB, WS_VA = 256 * MiB, WS_QG = 288 * MiB, WS_KG = 304 * MiB, WS_VG = 320 * MiB, WS_RG = 352 * MiB;
constexpr size_t WS_QX = 192 * MiB, WS_OX = 256 * MiB;
constexpr size_t WS_U = 192 * MiB;
constexpr size_t WS_QE = 384 * MiB, WS_DEC = 400 * MiB;
constexpr size_t WS_END = 448 * MiB;
constexpr int CW_Q = 512;
constexpr int CW_BAR = 1024;

constexpr int RING_OFF = 0, RING_BYTES = 131072;
constexpr int LDSCTL_OFF = RING_BYTES, MISC_OFF = LDSCTL_OFF + 320;
constexpr int LDS_BYTES = 147456;
#define GAS __attribute__((address_space(1)))
#define LAS __attribute__((address_space(3)))
typedef unsigned short bf16;
typedef unsigned v4u __attribute__((ext_vector_type(4)));
typedef float f32x4 __attribute__((ext_vector_type(4)));
typedef short bf16x8 __attribute__((ext_vector_type(8)));
typedef GAS unsigned gu32;
typedef GAS unsigned long long gu64;
#define RLX_AGENT __ATOMIC_RELAXED, __HIP_MEMORY_SCOPE_AGENT
#define LDS_WAIT() asm volatile("s_waitcnt lgkmcnt(0)" ::: "memory")
#define VM_WAIT() asm volatile("s_waitcnt vmcnt(0)" ::: "memory")
__device__ __forceinline__ unsigned long long rt() { return __builtin_amdgcn_s_memrealtime(); }
__device__ __forceinline__ unsigned f2bf(float f) { unsigned u = __builtin_bit_cast(unsigned, f); return (u + 0x7fffu + ((u >> 16) & 1u)) >> 16; }
__device__ __forceinline__ unsigned pk2(float lo, float hi) { return f2bf(lo) | (f2bf(hi) << 16); }
#define XB_TMO      128
#define XB_XCNT(j)  (256  + 64 * (j))
#define XB_XSUB(j)  (1280 + 64 * (j))
#define XB_XGEN(j)  (2304 + 64 * (j))
#define XB_TOP      3328
#define XB_TOPGEN   3392
#define XCD_BAR_WORDS 3456
#define XB_SPIN_CAP (1u << 18)

__device__ __forceinline__ unsigned xb_ld(unsigned* p)              { return __hip_atomic_load(p, __ATOMIC_RELAXED, __HIP_MEMORY_SCOPE_AGENT); }
__device__ __forceinline__ unsigned xb_add(unsigned* p, unsigned v) { return __hip_atomic_fetch_add(p, v, __ATOMIC_RELAXED, __HIP_MEMORY_SCOPE_AGENT); }
__device__ __forceinline__ unsigned xb_xcc_id() { return (unsigned)__builtin_amdgcn_s_getreg((3 << 11) | 20) & 0xFu; }
#define XB_SPIN(cond, bar) do { unsigned _sp = 0; while (cond) { __builtin_amdgcn_s_sleep(1); \
    if ((++_sp & 255u) == 0u) { if (xb_ld(&(bar)[XB_TMO])) break; if (_sp > XB_SPIN_CAP) { atomicAdd(&(bar)[XB_TMO], 1u); break; } } } } while (0)

struct XcdBarrier {
    unsigned* bar; unsigned x;
    volatile LAS unsigned* st;
};

__device__ __forceinline__ XcdBarrier xcd_barrier_post(unsigned* bar, volatile LAS unsigned* st) {
    XcdBarrier b; b.bar = bar; b.x = xb_xcc_id(); b.st = st;
    if (threadIdx.x == 0) (void)xb_add(&bar[XB_XCNT(b.x)], 1u);
    return b;
}
__device__ __forceinline__ void xcd_barrier_complete(unsigned* bar, unsigned x, unsigned& nloc, unsigned& nx) {
    const unsigned G = gridDim.x * gridDim.y * gridDim.z;
    unsigned sum, cnt, mine, sp = 0u;
    for (;;) {
        sum = 0u; cnt = 0u; mine = 0u;
#pragma unroll
        for (unsigned j = 0; j < 16; ++j) { const unsigned c = xb_ld(&bar[XB_XCNT(j)]); sum += c; cnt += (c > 0u) ? 1u : 0u; mine = (j == x) ? c : mine; }
        if (sum == G) break;
        __builtin_amdgcn_s_sleep(1);
        if ((++sp & 255u) == 0u) { if (xb_ld(&bar[XB_TMO])) break; if (sp > XB_SPIN_CAP) { atomicAdd(&bar[XB_TMO], 1u); break; } }
    }
    nloc = mine > 0u ? mine : 1u; nx = cnt > 0u ? cnt : 1u;
}

__device__ __forceinline__ void xcd_barrier(const XcdBarrier& b) {
    asm volatile("s_waitcnt vmcnt(0)" ::: "memory");
    __syncthreads();
    if (threadIdx.x == 0) {
        unsigned* bar = b.bar;
        __builtin_amdgcn_s_waitcnt(0);
        unsigned nloc = b.st[0], nx = b.st[1];
        if (nloc == 0u) { xcd_barrier_complete(bar, b.x, nloc, nx); b.st[0] = nloc; b.st[1] = nx; }
        const unsigned old = xb_add(&bar[XB_XSUB(b.x)], 1u);
        const unsigned gen = old / nloc;
        if (old + 1u == (gen + 1u) * nloc) {
            __builtin_amdgcn_fence(__ATOMIC_RELEASE, "agent");
            asm volatile("s_waitcnt vmcnt(0)" ::: "memory");
            const unsigned og = xb_add(&bar[XB_TOP], 1u);
            const unsigned tg = og / nx;
            if (og + 1u == (tg + 1u) * nx) xb_add(&bar[XB_TOPGEN], 1u);
            else XB_SPIN(xb_ld(&bar[XB_TOPGEN]) == tg, bar);
            __builtin_amdgcn_fence(__ATOMIC_ACQUIRE, "agent");
            xb_add(&bar[XB_XGEN(b.x)], 1u);
            asm volatile("s_waitcnt vmcnt(0)" ::: "memory");
        } else {
            XB_SPIN(xb_ld(&bar[XB_XGEN(b.x)]) == gen, bar);
            __builtin_amdgcn_fence(__ATOMIC_ACQUIRE, "agent");
            asm volatile("s_waitcnt vmcnt(0)" ::: "memory");
        }
    }
    __syncthreads();
}
struct Ctx {
    unsigned char* lds;
    LAS unsigned char* ldsl;
    int tid, lane, wave, gw, ngw, G, bid;
    const float *x, *mem, *rp, *norm_mix, *w_in, *w_gate_up, *b_gate, *g_norm, *w_out, *norm_xattn, *norm_mem, *w_xq, *w_xkv, *w_xo, *norm_mlp, *w_up, *w_down, *norm_final;
    float* out; unsigned char* ws;
};
__device__ __forceinline__ float wave_sum(float v) {
#pragma unroll
    for (int o = 1; o < 64; o <<= 1) v += __shfl_xor(v, o);
    return v;
}
__device__ __forceinline__ float wave_max(float v) {
#pragma unroll
    for (int o = 1; o < 64; o <<= 1) v = fmaxf(v, __shfl_xor(v, o));
    return v;
}
__device__ __forceinline__ float bf2f(bf16 b) { return __builtin_bit_cast(float, (unsigned)b << 16); }
__device__ __forceinline__ float bflo(unsigned w) { return __builtin_bit_cast(float, w << 16); }
__device__ __forceinline__ float bfhi(unsigned w) { return __builtin_bit_cast(float, w & 0xffff0000u); }

__host__ __device__ __forceinline__ int rel_bucket(int d) {
    if (d < 16) return d;
    int b = 16;
    b += (d >= 19); b += (d >= 21); b += (d >= 24); b += (d >= 27); b += (d >= 31); b += (d >= 35); b += (d >= 40); b += (d >= 46);
    b += (d >= 52); b += (d >= 59); b += (d >= 67); b += (d >= 77); b += (d >= 87); b += (d >= 99); b += (d >= 113);
    return b;
}

__host__ __device__ __forceinline__ int win_row(int n) { return n < 2560 ? n : (n < 2576 ? 3072 + (n - 2560) : n - 16); }
template <bool MAPWIN>
__device__ __forceinline__ void p0_transpose_item(const float* W, int K, int N, bf16* WT, LAS float* scr, int item, int lane) {
    const int nblk = (N + 31) / 32, kb = item / nblk, nb = item % nblk, k0 = 64 * kb, n0 = 32 * nb;
    const int col = n0 + (lane & 31);
#pragma unroll 8
    for (int i = 0; i < 32; ++i) { const int kk = 2 * i + (lane >> 5); scr[kk * 33 + (lane & 31)] = col < N ? W[(size_t)(k0 + kk) * N + col] : 0.f; }
    LDS_WAIT(); asm volatile("" ::: "memory");
    const int c = lane & 7;
#pragma unroll
    for (int j = 0; j < 4; ++j) { const int n = (lane >> 3) + 8 * j; const LAS float* s = scr + (8 * c) * 33 + n;
        v4u o; o.x = pk2(s[0 * 33], s[1 * 33]); o.y = pk2(s[2 * 33], s[3 * 33]); o.z = pk2(s[4 * 33], s[5 * 33]); o.w = pk2(s[6 * 33], s[7 * 33]);
        if (n0 + n < N) { const int r = MAPWIN ? win_row(n0 + n) : (n0 + n); *(GAS v4u*)(WT + (size_t)r * K + k0 + 8 * c) = o; } }
    LDS_WAIT(); asm volatile("" ::: "memory");
}
__device__ __forceinline__ void rms_row_to_bf16(const float* xrow, const float* gain, bf16* orow, int lane) {
    const GAS f32x4* xr = (const GAS f32x4*)xrow + lane; const GAS f32x4* gr = (const GAS f32x4*)gain + lane;
    f32x4 v[4]; float s = 0.f;
#pragma unroll
    for (int j = 0; j < 4; ++j) { v[j] = xr[64 * j]; s += (v[j].x * v[j].x + v[j].y * v[j].y) + (v[j].z * v[j].z + v[j].w * v[j].w); }
    const float rstd = 1.f / sqrtf(wave_sum(s) * (1.f / 1024.f) + EPS);
    GAS unsigned long long* o8 = (GAS unsigned long long*)orow + lane;
#pragma unroll
    for (int j = 0; j < 4; ++j) { const f32x4 g = gr[64 * j];
        o8[64 * j] = (unsigned long long)pk2(v[j].x * rstd * g.x, v[j].y * rstd * g.y) | ((unsigned long long)pk2(v[j].z * rstd * g.z, v[j].w * rstd * g.w) << 32); }
}
__device__ __forceinline__ void p0_prologue(const Ctx& F) {
    LAS float* scr = (LAS float*)(F.ldsl + RING_OFF + F.wave * 16384);
    unsigned char* ws = F.ws;
    constexpr int I_IN = 16 * 97, I_SQ = 16 * 32, I_KV = 16 * 64, I_UP = 16 * 128, I_DN = 64 * 32;
    constexpr int NITEMS = I_IN + 3 * I_SQ + I_KV + I_UP + I_DN;
    for (int it = F.gw; it < NITEMS; it += F.ngw) {
        int r = it;
        if (r < I_IN) { p0_transpose_item<true>(F.w_in, 1024, 3088, (bf16*)(ws + WS_WIN), scr, r, F.lane); continue; } r -= I_IN;
        if (r < I_SQ) { p0_transpose_item<false>(F.w_out, 1024, 1024, (bf16*)(ws + WS_WOUT), scr, r, F.lane); continue; } r -= I_SQ;
        if (r < I_SQ) { p0_transpose_item<false>(F.w_xq, 1024, 1024, (bf16*)(ws + WS_WXQ), scr, r, F.lane); continue; } r -= I_SQ;
        if (r < I_KV) { p0_transpose_item<false>(F.w_xkv, 1024, 2048, (bf16*)(ws + WS_WXKV), scr, r, F.lane); continue; } r -= I_KV;
        if (r < I_SQ) { p0_transpose_item<false>(F.w_xo, 1024, 1024, (bf16*)(ws + WS_WXO), scr, r, F.lane); continue; } r -= I_SQ;
        if (r < I_UP) { p0_transpose_item<false>(F.w_up, 1024, 4096, (bf16*)(ws + WS_WUP), scr, r, F.lane); continue; } r -= I_UP;
        p0_transpose_item<false>(F.w_down, 4096, 1024, (bf16*)(ws + WS_WDN), scr, r, F.lane);
    }
    const int gt = F.bid * (NWAVES * 64) + F.tid, ngt = F.G * NWAVES * 64;
    {
        GAS v4u* z = (GAS v4u*)(ws + WS_WIN + (size_t)3088 * 2048);
        for (int i = gt; i < 240 * 128; i += ngt) z[i] = (v4u){0u, 0u, 0u, 0u};
    }
    {
        GAS v4u* z = (GAS v4u*)(ws + WS_SSQ1);
        for (int i = gt; i < (3 * 128 * 1024 + 256 * 1024) / 16; i += ngt) z[i] = (v4u){0u, 0u, 0u, 0u};
    }
    if (F.bid == 0) {
        float* bt = (float*)(ws + WS_BIAS);
        for (int i = F.tid; i < 8 * 128; i += NWAVES * 64) { const int h = i >> 7, d = i & 127; bt[i] = F.rp[rel_bucket(d) * 8 + h] * LOG2E; }
    }
    for (int m = F.gw; m < M; m += F.ngw) rms_row_to_bf16(F.x + (size_t)m * DM, F.norm_mix, (bf16*)(ws + WS_HA) + (size_t)m * DM, F.lane);
    for (int m = F.gw; m < MM; m += F.ngw) rms_row_to_bf16(F.mem + (size_t)m * DM, F.norm_mem, (bf16*)(ws + WS_MN) + (size_t)m * DM, F.lane);
}

__device__ __forceinline__ void moba_naive(const Ctx& F) {
    float* sc = (float*)(F.lds + F.wave * 4096);
    const bf16* QA = (const bf16*)(F.ws + WS_QA); const bf16* KA = (const bf16*)(F.ws + WS_KA); const bf16* VA = (const bf16*)(F.ws + WS_VA);
    const float* ksum = (const float*)(F.ws + WS_KSUM); const float* bias = (const float*)(F.ws + WS_BIAS);
    bf16* MIX = (bf16*)(F.ws + WS_MIX);
    const int lane = F.lane;
    for (int task = F.gw; task < M * AH; task += F.ngw) {
        const int h = task / M, row = task % M;
        const int b = row >> 11, t = row & 2047, qb = t >> 8;
        const bf16* qrow = QA + (size_t)row * AW + h * AHD;
        float q[64];
#pragma unroll
        for (int c = 0; c < 8; ++c) { const v4u w = *(const v4u*)(qrow + 8 * c);
            q[8 * c + 0] = bflo(w.x); q[8 * c + 1] = bfhi(w.x); q[8 * c + 2] = bflo(w.y); q[8 * c + 3] = bfhi(w.y);
            q[8 * c + 4] = bflo(w.z); q[8 * c + 5] = bfhi(w.z); q[8 * c + 6] = bflo(w.w); q[8 * c + 7] = bfhi(w.w); }
        const float qd = bf2f(qrow[lane]);
        float gate[8];
#pragma unroll
        for (int j = 0; j < 8; ++j) { const float g = wave_sum(qd * ksum[(size_t)(b * 8 + j) * 512 + h * 64 + lane]); gate[j] = (j < qb) ? g : -INFINITY; }
        unsigned sel = 0u;
#pragma unroll
        for (int r = 0; r < 3; ++r) { int best = -1; float bv = -INFINITY;
#pragma unroll
            for (int j = 0; j < 8; ++j) { const bool ok = !((sel >> j) & 1u) && (j < qb) && (gate[j] > bv); if (ok) { bv = gate[j]; best = j; } }
            if (best >= 0) sel |= 1u << best; }
        sel |= 1u << qb;
        sel = (unsigned)__builtin_amdgcn_readfirstlane((int)sel);
        int nb = 0; float mx = -INFINITY;
        for (int j = 0; j <= qb; ++j) {
            if (!((sel >> j) & 1u)) continue;
            for (int kk = 0; kk < 4; ++kk) {
                const int kpos = j * 256 + kk * 64 + lane; const int d = t - kpos;
                const bf16* krow = KA + (size_t)(b * SEQ + kpos) * AW + h * AHD;
                float s = 0.f;
#pragma unroll
                for (int c = 0; c < 8; ++c) { const v4u w = *(const v4u*)(krow + 8 * c);
                    s += q[8 * c + 0] * bflo(w.x) + q[8 * c + 1] * bfhi(w.x) + q[8 * c + 2] * bflo(w.y) + q[8 * c + 3] * bfhi(w.y)
                       + q[8 * c + 4] * bflo(w.z) + q[8 * c + 5] * bfhi(w.z) + q[8 * c + 6] * bflo(w.w) + q[8 * c + 7] * bfhi(w.w); }
                if (d >= 0) s += bias[h * 128 + (d < 127 ? d : 127)]; else s = -INFINITY;
                sc[nb * 256 + kk * 64 + lane] = s; mx = fmaxf(mx, s);
            }
            ++nb;
        }
        mx = wave_max(mx);
        float sum = 0.f;
        for (int i = lane; i < nb * 256; i += 64) { const float p = exp2f(sc[i] - mx); sc[i] = p; sum += p; }
        sum = wave_sum(sum);
        asm volatile("s_waitcnt lgkmcnt(0)" ::: "memory");
        float o = 0.f; int ib = 0;
        for (int j = 0; j <= qb; ++j) {
            if (!((sel >> j) & 1u)) continue;
            const bf16* vcol = VA + (size_t)(b * SEQ + j * 256) * AW + h * AHD + lane;
#pragma unroll 8
            for (int k = 0; k < 256; ++k) o += sc[ib * 256 + k] * bf2f(vcol[(size_t)k * AW]);
            ++ib;
        }
        MIX[(size_t)row * DM + h * AHD + lane] = (bf16)f2bf(o / sum);
        asm volatile("s_waitcnt lgkmcnt(0)" ::: "memory");
    }
}

__device__ __forceinline__ float log_sigmoid(float z) { return z < 0.f ? z - log1pf(expf(z)) : -log1pf(expf(-z)); }
__device__ __forceinline__ void gla_naive(const Ctx& F) {
    constexpr int TB = 16;
    float* qs = (float*)F.lds;
    float* ks = qs + TB * 64;
    float* as_ = ks + TB * 64;
    float* vs = as_ + TB * 64;
    float* gl = vs + TB * 128;
    float* part = gl + TB * 16;
    float* ob = part + 2 * 4 * 128;
    const bf16* QG = (const bf16*)(F.ws + WS_QG); const bf16* KG = (const bf16*)(F.ws + WS_KG); const bf16* VG = (const bf16*)(F.ws + WS_VG); const bf16* RG = (const bf16*)(F.ws + WS_RG);
    const float* GLR = (const float*)(F.ws + WS_GLR); bf16* MIX = (bf16*)(F.ws + WS_MIX);
    const int tid = F.tid, dv = tid & 127, g4 = tid >> 7;
    for (int chain = F.bid; chain < BATCH * GH; chain += F.G) {
        const int b = chain >> 2, hg = chain & 3;
        float S[16];
#pragma unroll
        for (int i = 0; i < 16; ++i) S[i] = 0.f;
        for (int t0 = 0; t0 < SEQ; t0 += TB) {
            const size_t r0 = (size_t)b * SEQ + t0;
            __syncthreads();
            for (int i = tid; i < TB * 64; i += 512) { const int tt = i >> 6, d = i & 63; qs[i] = bf2f(QG[(r0 + tt) * GKW + hg * 64 + d]); ks[i] = bf2f(KG[(r0 + tt) * GKW + hg * 64 + d]); }
            for (int i = tid; i < TB * 128; i += 512) { const int tt = i >> 7, d = i & 127; vs[i] = bf2f(VG[(r0 + tt) * GW + hg * 128 + d]); }
            if (tid < TB * 16) gl[tid] = GLR[(r0 + (tid >> 4)) * 16 + (tid & 15)];
            __syncthreads();
            for (int i = tid; i < TB * 64; i += 512) { const int tt = i >> 6, d = i & 63; float z = F.b_gate[hg * 64 + d];
#pragma unroll
                for (int r = 0; r < 16; ++r) z += gl[tt * 16 + r] * F.w_gate_up[r * GKW + hg * 64 + d];
                as_[i] = expf(log_sigmoid(z) * (1.0f / 16.0f)); }
            __syncthreads();
            for (int tt = 0; tt < TB; ++tt) {
                float po = 0.f; const float vv = vs[tt * 128 + dv];
#pragma unroll
                for (int i = 0; i < 16; ++i) { const int dk = 16 * g4 + i; S[i] = as_[tt * 64 + dk] * S[i] + ks[tt * 64 + dk] * vv; po += qs[tt * 64 + dk] * S[i]; }
                part[((tt & 1) * 4 + g4) * 128 + dv] = po;
                __syncthreads();
                if (tid < 128) ob[tt * 128 + tid] = (part[((tt & 1) * 4 + 0) * 128 + tid] + part[((tt & 1) * 4 + 1) * 128 + tid]) + (part[((tt & 1) * 4 + 2) * 128 + tid] + part[((tt & 1) * 4 + 3) * 128 + tid]);
            }
            __syncthreads();
#pragma unroll
            for (int k = 0; k < 2; ++k) { const int tt = 2 * F.wave + k; const size_t row = r0 + tt;
                const float o0 = ob[tt * 128 + F.lane], o1 = ob[tt * 128 + 64 + F.lane];
                const float rstd = 1.f / sqrtf(wave_sum(o0 * o0 + o1 * o1) * (1.f / 128.f) + EPS);
                const float r0v = bf2f(RG[row * GW + hg * 128 + F.lane]), r1v = bf2f(RG[row * GW + hg * 128 + 64 + F.lane]);
                const float y0 = o0 * rstd * F.g_norm[F.lane] * (r0v / (1.f + expf(-r0v))), y1 = o1 * rstd * F.g_norm[64 + F.lane] * (r1v / (1.f + expf(-r1v)));
                MIX[row * DM + AW + hg * 128 + F.lane] = (bf16)f2bf(y0); MIX[row * DM + AW + hg * 128 + 64 + F.lane] = (bf16)f2bf(y1); }
        }
        __syncthreads();
    }
}

__device__ __forceinline__ void xattn_naive(const Ctx& F) {
    float* qs = (float*)(F.lds + F.wave * 2048);
    float* sc = qs + 256;
    const bf16* QX = (const bf16*)(F.ws + WS_QX); const bf16* KX = (const bf16*)(F.ws + WS_KX); const bf16* VX = (const bf16*)(F.ws + WS_VX); bf16* OX = (bf16*)(F.ws + WS_OX);
    const int lane = F.lane;
    for (int task = F.gw; task < M * XH; task += F.ngw) {
        const int h = task / M, row = task % M, b = row >> 11;
        {   const unsigned long long w = *(const unsigned long long*)(QX + (size_t)row * DM + h * XHD + 4 * lane);
            qs[4 * lane + 0] = bflo((unsigned)w); qs[4 * lane + 1] = bfhi((unsigned)w); qs[4 * lane + 2] = bflo((unsigned)(w >> 32)); qs[4 * lane + 3] = bfhi((unsigned)(w >> 32)); }
        asm volatile("s_waitcnt lgkmcnt(0)" ::: "memory");
        float mx = -INFINITY;
        for (int kk = 0; kk < 4; ++kk) {
            const bf16* krow = KX + (size_t)(b * MEMLEN + kk * 64 + lane) * DM + h * XHD;
            float s = 0.f;
#pragma unroll 4
            for (int c = 0; c < 32; ++c) { const v4u w = *(const v4u*)(krow + 8 * c); const float* qq = qs + 8 * c;
                s += qq[0] * bflo(w.x) + qq[1] * bfhi(w.x) + qq[2] * bflo(w.y) + qq[3] * bfhi(w.y) + qq[4] * bflo(w.z) + qq[5] * bfhi(w.z) + qq[6] * bflo(w.w) + qq[7] * bfhi(w.w); }
            sc[kk * 64 + lane] = s; mx = fmaxf(mx, s);
        }
        mx = wave_max(mx);
        float sum = 0.f;
        for (int kk = 0; kk < 4; ++kk) { const float p = exp2f(sc[kk * 64 + lane] - mx); sc[kk * 64 + lane] = p; sum += p; }
        sum = wave_sum(sum);
        asm volatile("s_waitcnt lgkmcnt(0)" ::: "memory");
        float o0 = 0.f, o1 = 0.f, o2 = 0.f, o3 = 0.f;
        const bf16* vcol = VX + (size_t)(b * MEMLEN) * DM + h * XHD + 4 * lane;
#pragma unroll 8
        for (int k = 0; k < 256; ++k) { const unsigned long long w = *(const unsigned long long*)(vcol + (size_t)k * DM); const float p = sc[k];
            o0 += p * bflo((unsigned)w); o1 += p * bfhi((unsigned)w); o2 += p * bflo((unsigned)(w >> 32)); o3 += p * bfhi((unsigned)(w >> 32)); }
        const float inv = 1.f / sum;
        *(unsigned long long*)(OX + (size_t)row * DM + h * XHD + 4 * lane) = (unsigned long long)pk2(o0 * inv, o1 * inv) | ((unsigned long long)pk2(o2 * inv, o3 * inv) << 32);
        asm volatile("s_waitcnt lgkmcnt(0)" ::: "memory");
    }
}

__device__ __forceinline__ void final_norm(const Ctx& F) {
    const float* ssq = (const float*)(F.ws + WS_SSQ3);
    for (int m = F.gw; m < M; m += F.ngw) {
        GAS f32x4* xr = (GAS f32x4*)(F.out + (size_t)m * DM) + F.lane; const GAS f32x4* gr = (const GAS f32x4*)F.norm_final + F.lane;
        const float rstd = 1.f / sqrtf(ssq[m] * (1.f / 1024.f) + EPS);
#pragma unroll
        for (int j = 0; j < 4; ++j) { const f32x4 v = xr[64 * j], g = gr[64 * j]; xr[64 * j] = (f32x4){v.x * rstd * g.x, v.y * rstd * g.y, v.z * rstd * g.z, v.w * rstd * g.w}; }
    }
}

constexpr int NPHASE = 10;
struct Args { const float* in[18]; float* out; unsigned char* ws; int ph_lo, ph_hi, li, pad; };
__global__ void __launch_bounds__(NWAVES * 64, 2) mk_fwd(Args args) {
    extern __shared__ __attribute__((aligned(16))) unsigned char lds[];
    Ctx F;
    F.lds = lds; F.ldsl = (LAS unsigned char*)lds;
    F.tid = threadIdx.x; F.lane = F.tid & 63; F.wave = __builtin_amdgcn_readfirstlane(F.tid >> 6);
    F.G = gridDim.x; F.bid = blockIdx.x; F.gw = F.bid * NWAVES + F.wave; F.ngw = F.G * NWAVES;
    F.x = args.in[0]; F.mem = args.in[1]; F.rp = args.in[2]; F.norm_mix = args.in[3]; F.w_in = args.in[4]; F.w_gate_up = args.in[5]; F.b_gate = args.in[6]; F.g_norm = args.in[7];
    F.w_out = args.in[8]; F.norm_xattn = args.in[9]; F.norm_mem = args.in[10]; F.w_xq = args.in[11]; F.w_xkv = args.in[12]; F.w_xo = args.in[13]; F.norm_mlp = args.in[14];
    F.w_up = args.in[15]; F.w_down = args.in[16]; F.norm_final = args.in[17];
    F.out = args.out; F.ws = args.ws;
    unsigned char* ws = args.ws;
    volatile LAS unsigned* MISC = (volatile LAS unsigned*)(F.ldsl + MISC_OFF);
    for (int u = F.tid; u < (LDS_BYTES - LDSCTL_OFF) / 4; u += NWAVES * 64) ((LAS unsigned*)(F.ldsl + LDSCTL_OFF))[u] = 0u;
    __syncthreads();
    const int lo = args.ph_lo, hi = args.ph_hi;
    XcdBarrier bar; bar.bar = (unsigned*)(ws + WS_CTL) + CW_BAR + args.li * XCD_BAR_WORDS; bar.x = 0; bar.st = nullptr;
    bar = xcd_barrier_post((unsigned*)(ws + WS_CTL) + CW_BAR + args.li * XCD_BAR_WORDS, MISC + 8);
#define IN(k) (lo <= (k) && (k) < hi)
#define SEAM(k) do { if (IN(k) && IN((k) + 1)) xcd_barrier(bar); } while (0)
    float* ssq1 = (float*)(ws + WS_SSQ1); float* ssq2 = (float*)(ws + WS_SSQ2); float* ssq3 = (float*)(ws + WS_SSQ3);
    bf16* HA = (bf16*)(ws + WS_HA);

    if (IN(0)) { p0_prologue(F); SEAM(0); }

    if (IN(1)) {
        {   pg8::Gemm g{HA, (const bf16*)(ws + WS_WIN), M, NIN, DM}; pg8::StaticOrder S; S.init(M, NIN, F.G, F.bid);
            pg8::EpiInProj E{(bf16*)(ws + WS_QA), (bf16*)(ws + WS_KA), (bf16*)(ws + WS_VA), (bf16*)(ws + WS_QG), (bf16*)(ws + WS_KG), (bf16*)(ws + WS_VG), (bf16*)(ws + WS_RG),
                             (float*)(ws + WS_GLR), (float*)(ws + WS_KSUM), C2A, 0.125f};
            pg8::gemm_phase<pg8::EpiInProj, pg8::StaticOrder, PG8_ALIGN, PG8_SP2>(F.ldsl + RING_OFF, g, S, E); }
        {   pg8::Gemm g{(const bf16*)(ws + WS_MN), (const bf16*)(ws + WS_WXKV), MM, 2048, DM}; pg8::StaticOrder S; S.init(MM, 2048, F.G, F.bid);
            pg8::EpiSplitBf16 E{(bf16*)(ws + WS_KX), (bf16*)(ws + WS_VX), 4, DM};
            pg8::gemm_phase<pg8::EpiSplitBf16, pg8::StaticOrder, PG8_ALIGN, PG8_SP2>(F.ldsl + RING_OFF, g, S, E); }
        SEAM(1);
    }
    if (IN(2)) {
        {   float* GOI = F.out; float* GU = F.out + (size_t)16 * 1024 * 1024;
            attn_body::gla::gla_pass1((char*)lds + RING_OFF, (int)F.G, (int)F.bid, (const attn_body::bf16*)(ws + WS_QG), (const attn_body::bf16*)(ws + WS_KG), (const attn_body::bf16*)(ws + WS_VG),
                                      (const float*)(ws + WS_GLR), F.w_gate_up, F.b_gate, (attn_body::bf16*)(ws + WS_QE), (float*)(ws + WS_DEC), GU, GOI);
            xcd_barrier(bar);
            if (F.bid < BATCH * GH)
                attn_body::gla::gla_chain((char*)lds + RING_OFF, (int)F.bid, (const attn_body::bf16*)(ws + WS_QE), (const float*)(ws + WS_DEC), GU, GOI, (const attn_body::bf16*)(ws + WS_RG), F.g_norm, (attn_body::bf16*)(ws + WS_MIX));
        }
        const attn_body::AttnTensors AT{(const attn_body::bf16*)(ws + WS_QA), (const attn_body::bf16*)(ws + WS_KA), (const attn_body::bf16*)(ws + WS_VA), (attn_body::bf16*)(ws + WS_MIX),
                                        (const float*)(ws + WS_KSUM), (const float*)(ws + WS_BIAS)};
        {
            volatile LAS unsigned* qw = MISC + 16; gu32* ctl = (gu32*)(ws + WS_CTL);
            const int myx = F.bid & 7;
            for (int pass = 0; pass < 8; ++pass) { const int x = (myx + pass) & 7;
                for (;;) {
                    __syncthreads();
                    if (F.tid == 0) qw[0] = __hip_atomic_fetch_add(ctl + CW_Q + 64 * x, 1u, RLX_AGENT);
                    __syncthreads();
                    const unsigned u = (unsigned)__builtin_amdgcn_readfirstlane((int)qw[0]);
                    if (u >= 128u) break;
                    const int qb = 7 - (int)(u >> 4), bh = 8 * (int)(u & 15u) + x;
                    attn_body::attn_unit<8>(bh >> 3, bh & 7, qb, AT.Q, AT.K, AT.V, AT.O, AT.ksum, AT.biasl2, (char*)lds + RING_OFF);
                }
            }
        }
        SEAM(2);
    }
    if (IN(3)) {
        pg8::Gemm g{(const bf16*)(ws + WS_MIX), (const bf16*)(ws + WS_WOUT), M, DM, DM}; pg8::StaticOrder S; S.init(M, DM, F.G, F.bid);
        pg8::EpiResidual<true> E{F.x, F.out, HA, F.norm_xattn, ssq1};
        pg8::gemm_phase<pg8::EpiResidual<true>, pg8::StaticOrder, PG8_ALIGN, PG8_SP2>(F.ldsl + RING_OFF, g, S, E);
        SEAM(3);
    }
    if (IN(4)) {
        pg8::Gemm g{HA, (const bf16*)(ws + WS_WXQ), M, DM, DM}; pg8::StaticOrder S; S.init(M, DM, F.G, F.bid);
        pg8::EpiRowScale<0> E{(bf16*)(ws + WS_QX), DM, ssq1, EPS, C2X};
        pg8::gemm_phase<pg8::EpiRowScale<0>, pg8::StaticOrder, PG8_ALIGN, PG8_SP2>(F.ldsl + RING_OFF, g, S, E);
        SEAM(4);
    }
    if (IN(5)) {
        attn_body::xa::xattn_phase((char*)lds + RING_OFF, (const attn_body::bf16*)(ws + WS_QX), (const attn_body::bf16*)(ws + WS_KX), (const attn_body::bf16*)(ws + WS_VX), (attn_body::bf16*)(ws + WS_OX), (int)F.G, (int)F.bid);
        SEAM(5);
    }
    if (IN(6)) {
        pg8::Gemm g{(const bf16*)(ws + WS_OX), (const bf16*)(ws + WS_WXO), M, DM, DM}; pg8::StaticOrder S; S.init(M, DM, F.G, F.bid);
        pg8::EpiResidual<true> E{F.out, F.out, HA, F.norm_mlp, ssq2};
        pg8::gemm_phase<pg8::EpiResidual<true>, pg8::StaticOrder, PG8_ALIGN, PG8_SP2>(F.ldsl + RING_OFF, g, S, E);
        SEAM(6);
    }
    if (IN(7)) {
        pg8::Gemm g{HA, (const bf16*)(ws + WS_WUP), M, FF, DM}; pg8::StaticOrder S; S.init(M, FF, F.G, F.bid);
        pg8::EpiRowScale<1> E{(bf16*)(ws + WS_U), FF, ssq2, EPS, 1.0f};
        pg8::gemm_phase<pg8::EpiRowScale<1>, pg8::StaticOrder, PG8_ALIGN, PG8_SP2>(F.ldsl + RING_OFF, g, S, E);
        SEAM(7);
    }
    if (IN(8)) {
        pg8::Gemm g{(const bf16*)(ws + WS_U), (const bf16*)(ws + WS_WDN), M, DM, FF}; pg8::StaticOrder S; S.init(M, DM, F.G, F.bid);
        pg8::EpiResidual<false> E{F.out, F.out, nullptr, nullptr, ssq3};
        pg8::gemm_phase<pg8::EpiResidual<false>, pg8::StaticOrder, PG8_ALIGN, PG8_SP2>(F.ldsl + RING_OFF, g, S, E);
        SEAM(8);
    }
    if (IN(9)) { final_norm(F); }
#undef IN
#undef SEAM
}

#ifndef MK_CUTS
#define MK_CUTS 0x0
#endif
extern "C" void kernel_launch(void* const* d_in, const int* in_sizes, int n_in, void* d_out, int out_size, void* d_ws, size_t ws_size, hipStream_t stream) {
    static int grid = 0;
    if (grid == 0) {
        if (n_in != 18 || out_size != M * DM || ws_size < WS_END) { fprintf(stderr, "kernel_launch: unexpected shapes (n_in %d out %d ws %zu)\n", n_in, out_size, ws_size); grid = -1; return; }
        int dev = 0, cus = 0;
        if (hipGetDevice(&dev) != hipSuccess || hipDeviceGetAttribute(&cus, hipDeviceAttributeMultiprocessorCount, dev) != hipSuccess) { grid = -1; return; }
        if (hipFuncSetAttribute((const void*)mk_fwd, hipFuncAttributeMaxDynamicSharedMemorySize, LDS_BYTES) != hipSuccess) { fprintf(stderr, "kernel_launch: hipFuncSetAttribute failed\n"); grid = -1; return; }
        (void)hipGetLastError();
        grid = cus;
    }
    if (grid < 0) return;
    (void)hipMemsetAsync((char*)d_ws + WS_CTL, 0, CTL_ZERO_BYTES, stream);
    Args a{};
    for (int i = 0; i < 18; ++i) a.in[i] = (const float*)d_in[i];
    a.out = (float*)d_out; a.ws = (unsigned char*)d_ws;
    int lo = 0, li = 0;
    for (int k = 0; k < NPHASE; ++k) {
        if (k == NPHASE - 1 || ((MK_CUTS >> k) & 1)) {
            a.ph_lo = lo; a.ph_hi = k + 1; a.li = li++;
            hipLaunchKernelGGL(mk_fwd, dim3(grid), dim3(NWAVES * 64), LDS_BYTES, stream, a);
            lo = k + 1;
        }
    }
}
```

```cpp
#include <hip/hip_runtime.h>
#include <cstdio>
#include <cstdint>
#include <cmath>
namespace pg8 {
#define PG8_LAS __attribute__((address_space(3)))
typedef unsigned short bf16_t;
typedef short bf16x8 __attribute__((ext_vector_type(8)));
typedef float f32x4 __attribute__((ext_vector_type(4)));
typedef unsigned u32x4 __attribute__((ext_vector_type(4)));
constexpr int BM = 256, BK = 64, HALF = 128, HTB = HALF * BK * 2  , STAGE_BYTES = 8 * HTB, NXCD = 8, WGM = 8;

__host__ __device__ __forceinline__ int lds_byte(int r, int c) { const int st = (r >> 4) * 2 + (c >> 5), rr = r & 15, cc = c & 31, ob = rr * 64 + cc * 2; return st * 1024 + (ob ^ (((ob >> 9) & 1) << 5)); }
__host__ __device__ __forceinline__ void stage_rc(int b, int& R, int& C) { const int st = b / 1024, sb = b % 1024, swz = sb ^ (((sb >> 9) & 1) << 5); R = (st >> 1) * 16 + swz / 64; C = (st & 1) * 32 + (swz % 64) / 2; }
__host__ __device__ __forceinline__ int perm32(int rho) { const int n = rho >> 4, i = rho & 15; return 8 * (i >> 2) + 4 * n + (i & 3); }

struct Unit { int pm, pn; };
struct Gemm { const bf16_t* A; const bf16_t* Bt; int M, N, K; };

struct StaticOrder {
    int nM, nN, nwg, G, c;
    __host__ __device__ void init(int M, int N, int G_, int c_) { nM = M / BM; nN = N / BM; nwg = nM * nN; G = G_; c = c_; }
    __host__ __device__ bool next(int i, Unit& u) const {
        const long L = (long)i * G + c; if (L >= nwg) return false;
        int wgid = (int)L; { const int q = nwg / NXCD, r = nwg % NXCD, xcd = wgid % NXCD, off = wgid / NXCD; wgid = (xcd < r ? xcd * (q + 1) : r * (q + 1) + (xcd - r) * q) + off; }
        const int nig = WGM * nN, gid = wgid / nig, fm = gid * WGM, gsz = (nM - fm) < WGM ? (nM - fm) : WGM;
        u.pm = fm + ((wgid % nig) % gsz); u.pn = (wgid % nig) / gsz; return true;
    }
    __device__ __forceinline__ void a_ready(const Unit&) const {}
    __device__ __forceinline__ void done(const Unit&) const {}
};
__device__ __forceinline__ unsigned cvt_pk_bf16(float lo, float hi) { unsigned r; asm volatile("v_cvt_pk_bf16_f32 %0, %1, %2" : "=v"(r) : "v"(lo), "v"(hi)); return r; }
typedef float f32x2 __attribute__((ext_vector_type(2)));
typedef unsigned u32x2e __attribute__((ext_vector_type(2)));
__device__ __forceinline__ u32x4 pack8(f32x4 v0, f32x4 v1) { u32x4 w; w.x = cvt_pk_bf16(v0[0], v0[1]); w.y = cvt_pk_bf16(v0[2], v0[3]); w.z = cvt_pk_bf16(v1[0], v1[1]); w.w = cvt_pk_bf16(v1[2], v1[3]); return w; }

struct EpiInProj {
    static constexpr bool PERM = true, AFTER_DRAIN = false;
    bf16_t *qa, *ka, *va, *qg, *kg, *vg, *rg; float* glr; float* ksum; float qa_scale, qg_scale;
    __device__ __forceinline__ void operator()(const f32x4 (&acc)[2][2][4][2], const Unit& u, int wr, int wc, int fr, int fq) const {
        const int pn = u.pn; const int row0 = u.pm * BM + wr * 64 + fr; const int cin = wc * 32 + 8 * fq;
        if (pn == 12) {
            if (wc == 0 && fq < 2) {
#pragma unroll
                for (int ai = 0; ai < 2; ++ai)
#pragma unroll
                    for (int m = 0; m < 4; ++m) { float* p = glr + (size_t)(row0 + ai * HALF + m * 16) * 16 + 8 * fq; *(f32x4*)p = acc[ai][0][m][0]; *(f32x4*)(p + 4) = acc[ai][0][m][1]; }
            }
            return;
        }
        bf16_t* base; int pitch, coff; float sc = 1.f;
        if (pn < 2) { base = qa; pitch = 512; coff = pn * 256; sc = qa_scale; }
        else if (pn < 4) { base = ka; pitch = 512; coff = (pn - 2) * 256; }
        else if (pn < 6) { base = va; pitch = 512; coff = (pn - 4) * 256; }
        else if (pn == 6) { base = qg; pitch = 256; coff = 0; sc = qg_scale; }
        else if (pn == 7) { base = kg; pitch = 256; coff = 0; }
        else if (pn < 10) { base = vg; pitch = 512; coff = (pn - 8) * 256; }
        else { base = rg; pitch = 512; coff = (pn - 10) * 256; }
#pragma unroll
        for (int ai = 0; ai < 2; ++ai)
#pragma unroll
            for (int m = 0; m < 4; ++m) { bf16_t* rowp = base + (size_t)(row0 + ai * HALF + m * 16) * pitch + coff + cin;
#pragma unroll
                for (int bj = 0; bj < 2; ++bj) *(u32x4*)(rowp + bj * HALF) = pack8(acc[ai][bj][m][0] * sc, acc[ai][bj][m][1] * sc); }
        if (pn == 2 || pn == 3) {
            float* kp = ksum + (size_t)u.pm * 512 + (pn - 2) * 256 + cin;
#pragma unroll
            for (int bj = 0; bj < 2; ++bj) {
                f32x4 s0 = {0.f, 0.f, 0.f, 0.f}, s1 = {0.f, 0.f, 0.f, 0.f};
#pragma unroll
                for (int ai = 0; ai < 2; ++ai)
#pragma unroll
                    for (int m = 0; m < 4; ++m) { s0 += acc[ai][bj][m][0]; s1 += acc[ai][bj][m][1]; }
#pragma unroll
                for (int e = 0; e < 4; ++e) {
#pragma unroll
                    for (int o = 1; o < 16; o <<= 1) { s0[e] += __shfl_xor(s0[e], o); s1[e] += __shfl_xor(s1[e], o); }
                }
                if (fr == 0) {
#pragma unroll
                    for (int e = 0; e < 4; ++e) { atomicAdd(kp + bj * HALF + e, s0[e]); atomicAdd(kp + bj * HALF + 4 + e, s1[e]); }
                }
            }
        }
    }
};

struct EpiSplitBf16 {
    static constexpr bool PERM = true, AFTER_DRAIN = false;
    bf16_t *o0, *o1; int split_tiles; int pitch;
    __device__ __forceinline__ void operator()(const f32x4 (&acc)[2][2][4][2], const Unit& u, int wr, int wc, int fr, int fq) const {
        const int row0 = u.pm * BM + wr * 64 + fr; const int t = u.pn >= split_tiles ? 1 : 0;
        bf16_t* base = t ? o1 : o0; const int col0 = (u.pn - t * split_tiles) * BM + wc * 32 + 8 * fq;
#pragma unroll
        for (int ai = 0; ai < 2; ++ai)
#pragma unroll
            for (int m = 0; m < 4; ++m) { bf16_t* rowp = base + (size_t)(row0 + ai * HALF + m * 16) * pitch + col0;
#pragma unroll
                for (int bj = 0; bj < 2; ++bj) *(u32x4*)(rowp + bj * HALF) = pack8(acc[ai][bj][m][0], acc[ai][bj][m][1]); }
    }
};

template <bool F32IN> struct EpiResidual {
    static constexpr bool PERM = true, AFTER_DRAIN = false;
    const void* xb; bf16_t* xo; float* ssq;
    __device__ __forceinline__ void operator()(const f32x4 (&acc)[2][2][4][2], const Unit& u, int wr, int wc, int fr, int fq) const {
        const int row0 = u.pm * BM + wr * 64 + fr; const int col0 = u.pn * BM + wc * 32 + 8 * fq;
#pragma unroll
        for (int ai = 0; ai < 2; ++ai)
#pragma unroll
            for (int m = 0; m < 4; ++m) { const int row = row0 + ai * HALF + m * 16; const size_t off = (size_t)row * 1024 + col0; float sq = 0.f;
#pragma unroll
                for (int bj = 0; bj < 2; ++bj) {
                    f32x4 b0, b1;
                    if (F32IN) { b0 = *(const f32x4*)((const float*)xb + off + bj * HALF); b1 = *(const f32x4*)((const float*)xb + off + bj * HALF + 4); }
                    else { const u32x4 w = *(const u32x4*)((const bf16_t*)xb + off + bj * HALF);
                        b0 = (f32x4){__builtin_bit_cast(float, w.x << 16), __builtin_bit_cast(float, w.x & 0xffff0000u), __builtin_bit_cast(float, w.y << 16), __builtin_bit_cast(float, w.y & 0xffff0000u)};
                        b1 = (f32x4){__builtin_bit_cast(float, w.z << 16), __builtin_bit_cast(float, w.z & 0xffff0000u), __builtin_bit_cast(float, w.w << 16), __builtin_bit_cast(float, w.w & 0xffff0000u)}; }
                    const f32x4 v0 = b0 + acc[ai][bj][m][0], v1 = b1 + acc[ai][bj][m][1];
                    *(u32x4*)(xo + off + bj * HALF) = pack8(v0, v1);
                    sq += (v0[0] * v0[0] + v0[1] * v0[1]) + (v0[2] * v0[2] + v0[3] * v0[3]) + (v1[0] * v1[0] + v1[1] * v1[1]) + (v1[2] * v1[2] + v1[3] * v1[3]);
                }
                sq += __shfl_xor(sq, 16); sq += __shfl_xor(sq, 32);
                if (fq == 0) atomicAdd(ssq + row, sq);
            }
    }
};

template <int ACT> struct EpiRowScale {
    static constexpr bool PERM = true, AFTER_DRAIN = false;
    bf16_t* out; int pitch; const float* ssq; float eps, scale;
    __device__ __forceinline__ void operator()(const f32x4 (&acc)[2][2][4][2], const Unit& u, int wr, int wc, int fr, int fq) const {
        const int row0 = u.pm * BM + wr * 64 + fr; const int col0 = u.pn * BM + wc * 32 + 8 * fq;
#pragma unroll
        for (int ai = 0; ai < 2; ++ai)
#pragma unroll
            for (int m = 0; m < 4; ++m) { const int row = row0 + ai * HALF + m * 16; const float rs = __builtin_amdgcn_rsqf(ssq[row] * (1.0f / 1024.0f) + eps) ;
                bf16_t* rowp = out + (size_t)row * pitch + col0;
#pragma unroll
                for (int bj = 0; bj < 2; ++bj) { f32x4 v0 = acc[ai][bj][m][0] * rs, v1 = acc[ai][bj][m][1] * rs;
                    if (ACT == 1) {
#pragma unroll
                        for (int e = 0; e < 4; ++e) { const float a = fmaxf(v0[e], 0.f), b = fmaxf(v1[e], 0.f); v0[e] = a * a; v1[e] = b * b; }
                    }
                    *(u32x4*)(rowp + bj * HALF) = pack8(v0 * scale, v1 * scale); }
            }
    }
};
template <class Epi, class Sched, bool ALIGN_EPI = false, bool SP2 = false>
__device__ __forceinline__ void gemm_phase(PG8_LAS unsigned char* lds, const Gemm g, const Sched& S, const Epi& E) {
    const int tid = threadIdx.x, wid = __builtin_amdgcn_readfirstlane(tid >> 6), lane = tid & 63, wr = wid >> 2, wc = wid & 3, fr = lane & 15, fq = lane >> 4;
    const int K = g.K, nt = K / BK;
    unsigned voffA[2], voffB[2];
#pragma unroll
    for (int i = 0; i < 2; ++i) { int R, C; stage_rc(tid * 16 + i * 8192, R, C); const int Rb = Epi::PERM ? ((R & ~31) + perm32(R & 31)) : R;
        voffA[i] = (unsigned)(R * K + C) * 2u; voffB[i] = (unsigned)(Rb * K + C) * 2u; }
    const size_t kstep = (size_t)(BK * 2);
    const size_t hstep = (size_t)HALF * K * 2;
    const size_t tstep = 2 * hstep;
    const unsigned ldsw = (unsigned)wid * 1024u;
    const int aoff = lds_byte(wr * 64 + fr, fq * 8), boff = lds_byte(wc * 32 + fr, fq * 8);
#define PG8_SA(b, h) (((b) * 2 + (h)) * HTB)
#define PG8_SB(b, h) ((4 + (b) * 2 + (h)) * HTB)
#define PG8_STAGE(bufoff, gbase, voff) do { _Pragma("unroll") for (int _i = 0; _i < 2; ++_i) \
        __builtin_amdgcn_global_load_lds((const unsigned*)((const char*)(gbase) + (voff)[_i]), (PG8_LAS unsigned*)(lds + (bufoff) + ldsw + _i * 8192), 16, 0, 0); } while (0)
#define PG8_LDA(dst, b, h) do { _Pragma("unroll") for (int m = 0; m < 4; ++m) _Pragma("unroll") for (int k = 0; k < 2; ++k) dst[m][k] = *(const PG8_LAS bf16x8*)(lds + PG8_SA(b, h) + aoff + m * 2048 + k * 1024); } while (0)
#define PG8_LDB(dst, b, h) do { _Pragma("unroll") for (int n = 0; n < 2; ++n) _Pragma("unroll") for (int k = 0; k < 2; ++k) dst[n][k] = *(const PG8_LAS bf16x8*)(lds + PG8_SB(b, h) + boff + n * 2048 + k * 1024); } while (0)
#define PG8_MMA(ai, bj, At, Bt) do { __builtin_amdgcn_s_setprio(1); _Pragma("unroll") for (int m = 0; m < 4; ++m) _Pragma("unroll") for (int n = 0; n < 2; ++n) _Pragma("unroll") for (int k = 0; k < 2; ++k) \
        acc[ai][bj][m][n] = __builtin_amdgcn_mfma_f32_16x16x32_bf16(Bt[n][k], At[m][k], acc[ai][bj][m][n], 0, 0, 0); __builtin_amdgcn_s_setprio(0); } while (0)
#define PG8_WAIT_V(n) asm volatile("s_waitcnt vmcnt(" #n ")" ::: "memory")
#define PG8_WAIT_L(n) asm volatile("s_waitcnt lgkmcnt(" #n ")" ::: "memory")
#define PG8_BAR __builtin_amdgcn_s_barrier()
#define PG8_SCHED __builtin_amdgcn_sched_barrier(0)
    Unit cur, nxt; int ui = 0;
    if (!S.next(0, cur)) return;
    f32x4 acc[2][2][4][2];
#pragma unroll
    for (int a = 0; a < 2; ++a)
#pragma unroll
        for (int b = 0; b < 2; ++b)
#pragma unroll
            for (int m = 0; m < 4; ++m)
#pragma unroll
                for (int n = 0; n < 2; ++n) acc[a][b][m][n] = (f32x4){0.f, 0.f, 0.f, 0.f};
    bf16x8 At[4][2], B0[2][2], B1[2][2];
    const char* cA = (const char*)g.A + (size_t)cur.pm * tstep; const char* cB = (const char*)g.Bt + (size_t)cur.pn * tstep;
    S.a_ready(cur);
    if constexpr (SP2) {
        PG8_STAGE(PG8_SB(0, 0), cB, voffB); PG8_STAGE(PG8_SB(0, 1), cB + hstep, voffB); PG8_STAGE(PG8_SA(0, 0), cA, voffA); PG8_STAGE(PG8_SA(0, 1), cA + hstep, voffA);
        if (wr == 1) PG8_BAR;
        PG8_WAIT_V(2); PG8_BAR;
        PG8_STAGE(PG8_SB(1, 0), cB + kstep, voffB); PG8_STAGE(PG8_SA(1, 0), cA + kstep, voffA); PG8_STAGE(PG8_SB(1, 1), cB + hstep + kstep, voffB);
        PG8_WAIT_V(6); PG8_BAR;
    } else {
        PG8_STAGE(PG8_SB(0, 0), cB, voffB); PG8_STAGE(PG8_SA(0, 0), cA, voffA); PG8_STAGE(PG8_SB(0, 1), cB + hstep, voffB); PG8_STAGE(PG8_SA(0, 1), cA + hstep, voffA);
        if (wr == 1) PG8_BAR;
        PG8_WAIT_V(4); PG8_BAR;
        PG8_STAGE(PG8_SB(1, 0), cB + kstep, voffB); PG8_STAGE(PG8_SA(1, 0), cA + kstep, voffA); PG8_STAGE(PG8_SB(1, 1), cB + hstep + kstep, voffB);
        PG8_WAIT_V(6); PG8_BAR;
    }
    for (;;) {
        const bool has_next = S.next(ui + 1, nxt);
        const char* nA = has_next ? (const char*)g.A + (size_t)nxt.pm * tstep : cA; const char* nB = has_next ? (const char*)g.Bt + (size_t)nxt.pn * tstep : cB;
        for (int t = 0; t < nt; t += 2) {
            const bool last = (t == nt - 2);
            const char* a1 = cA + (size_t)(t + 1) * kstep;
            const char* a2 = last ? nA : cA + (size_t)(t + 2) * kstep; const char* b2 = last ? nB : cB + (size_t)(t + 2) * kstep;
            const char* a3 = a2 + kstep; const char* b3 = b2 + kstep;
            if (last && has_next) S.a_ready(nxt);
            if constexpr (SP2) {
            PG8_LDB(B0, 0, 0); PG8_LDB(B1, 0, 1); PG8_SCHED; PG8_LDA(At, 0, 0); PG8_STAGE(PG8_SA(1, 1), a1 + hstep, voffA);
            PG8_WAIT_V(8); PG8_WAIT_L(0); PG8_BAR; PG8_MMA(0, 0, At, B0); PG8_MMA(0, 1, At, B1); PG8_BAR; PG8_SCHED;
            PG8_LDA(At, 0, 1); PG8_STAGE(PG8_SB(0, 0), b2, voffB); PG8_STAGE(PG8_SB(0, 1), b2 + hstep, voffB); PG8_STAGE(PG8_SA(0, 0), a2, voffA);
            PG8_WAIT_V(8); PG8_WAIT_L(0); PG8_BAR; PG8_MMA(1, 0, At, B0); PG8_MMA(1, 1, At, B1); PG8_BAR; PG8_SCHED;
            PG8_LDB(B0, 1, 0); PG8_LDB(B1, 1, 1); PG8_SCHED; PG8_LDA(At, 1, 0); PG8_STAGE(PG8_SA(0, 1), a2 + hstep, voffA);
            PG8_WAIT_V(8); PG8_WAIT_L(0); PG8_BAR; PG8_MMA(0, 0, At, B0); PG8_MMA(0, 1, At, B1); PG8_BAR; PG8_SCHED;
            PG8_LDA(At, 1, 1); PG8_STAGE(PG8_SB(1, 0), b3, voffB); PG8_STAGE(PG8_SB(1, 1), b3 + hstep, voffB); PG8_STAGE(PG8_SA(1, 0), a3, voffA);
            PG8_WAIT_V(8); PG8_WAIT_L(0); PG8_BAR; PG8_MMA(1, 0, At, B0); PG8_MMA(1, 1, At, B1); PG8_BAR; PG8_SCHED;
            } else {
            PG8_LDB(B0, 0, 0); PG8_SCHED; PG8_LDA(At, 0, 0); PG8_STAGE(PG8_SA(1, 1), a1 + hstep, voffA);
            PG8_WAIT_L(8); PG8_BAR; PG8_WAIT_L(0); PG8_MMA(0, 0, At, B0); PG8_BAR; PG8_SCHED;
            PG8_LDB(B1, 0, 1); PG8_STAGE(PG8_SB(0, 0), b2, voffB);
            PG8_BAR; PG8_WAIT_L(0); PG8_MMA(0, 1, At, B1); PG8_BAR;
            PG8_LDA(At, 0, 1); PG8_STAGE(PG8_SA(0, 0), a2, voffA);
            PG8_BAR; PG8_WAIT_L(0); PG8_MMA(1, 0, At, B0); PG8_BAR; PG8_SCHED;
            PG8_STAGE(PG8_SB(0, 1), b2 + hstep, voffB);
            PG8_WAIT_V(6); PG8_BAR; PG8_MMA(1, 1, At, B1); PG8_BAR;
            PG8_LDB(B0, 1, 0); PG8_SCHED; PG8_LDA(At, 1, 0); PG8_STAGE(PG8_SA(0, 1), a2 + hstep, voffA);
            PG8_WAIT_L(8); PG8_BAR; PG8_WAIT_L(0); PG8_MMA(0, 0, At, B0); PG8_BAR; PG8_SCHED;
            PG8_LDB(B1, 1, 1); PG8_STAGE(PG8_SB(1, 0), b3, voffB);
            PG8_BAR; PG8_WAIT_L(0); PG8_MMA(0, 1, At, B1); PG8_BAR;
            PG8_LDA(At, 1, 1); PG8_STAGE(PG8_SA(1, 0), a3, voffA);
            PG8_BAR; PG8_WAIT_L(0); PG8_MMA(1, 0, At, B0); PG8_BAR; PG8_SCHED;
            PG8_STAGE(PG8_SB(1, 1), b3 + hstep, voffB);
            PG8_WAIT_V(6); PG8_BAR; PG8_MMA(1, 1, At, B1); PG8_BAR;
            }
        }
        if constexpr (ALIGN_EPI) { if (wr == 0) PG8_BAR; }
        if constexpr (!Epi::AFTER_DRAIN) { E(acc, cur, wr, wc, fr, fq); S.done(cur); }
        if (!has_next) break;
#pragma unroll
        for (int a = 0; a < 2; ++a)
#pragma unroll
            for (int b = 0; b < 2; ++b)
#pragma unroll
                for (int m = 0; m < 4; ++m)
#pragma unroll
                    for (int n = 0; n < 2; ++n) acc[a][b][m][n] = (f32x4){0.f, 0.f, 0.f, 0.f};
        cur = nxt; cA = nA; cB = nB; ++ui;
        if constexpr (ALIGN_EPI) { if (wr == 1) PG8_BAR; }
    }
    PG8_WAIT_V(0);
    if constexpr (!ALIGN_EPI) { if (wr == 0) PG8_BAR; }
    PG8_BAR;
    if constexpr (Epi::AFTER_DRAIN) { E.fused(acc, cur, wr, wc, fr, fq, lds, wid, lane); S.done(cur); }
#undef PG8_SA
#undef PG8_SB
#undef PG8_STAGE
#undef PG8_LDA
#undef PG8_LDB
#undef PG8_MMA
#undef PG8_WAIT_V
#undef PG8_WAIT_L
#undef PG8_BAR
#undef PG8_SCHED
}
}
#include <hip/hip_bf16.h>
#include <cmath>
namespace attn_body {
using bf16=__hip_bfloat16;
using bf16x8=__attribute__((ext_vector_type(8)))short;
using s16x4=__attribute__((ext_vector_type(4)))short;
using f32x16=__attribute__((ext_vector_type(16)))float;
using u32x4=__attribute__((ext_vector_type(4)))unsigned;
constexpr int BATCH=16,NHEAD=8,SEQ=2048,D=64,DM=NHEAD*D,OPITCH=1024;
constexpr int NW=8,QBLK=32,QB=QBLK*NW,KVBLK=64,NQB=SEQ/QB;
constexpr int ATTN_PITCH=DM, ATTN_UNIT_ROWS=QB;
__device__ __forceinline__ int crow(int r,int hi){return (r&3)+8*(r>>2)+4*hi;}
#define SBAR() __builtin_amdgcn_sched_barrier(0)
constexpr int NSLOT=3, SLOTB=8192;
constexpr int LDS_K=0, LDS_V=NSLOT*SLOTB, LDS_WS=2*NSLOT*SLOTB, LDS_OST=LDS_WS+NW*64*4, LDS_LUT=LDS_OST+NW*4096, LDS_KMS=LDS_LUT+4096, LDS_BYTES=LDS_KMS+2048;
constexpr float C2=0.125f*1.4426950408889634f;
__device__ __forceinline__ void glds16(const void*gsrc,unsigned lds_dst){unsigned keep;
  asm volatile("s_mov_b32 %0, m0\n\ts_mov_b32 m0, %2\n\ts_nop 0\n\tglobal_load_lds_dwordx4 %1, off\n\ts_mov_b32 m0, %0":"=&s"(keep):"v"(gsrc),"s"(lds_dst):"memory");}
__device__ __forceinline__ float max3f(float a,float b,float c){float r;asm("v_max3_f32 %0, %1, %2, %3":"=v"(r):"v"(a),"v"(b),"v"(c));return r;}
__device__ __forceinline__ float max2f(float a,float b){float r;asm("v_max_f32_e32 %0, %1, %2":"=v"(r):"v"(a),"v"(b));return r;}
__device__ __forceinline__ float fadd_s(float a,float b){float r;asm("v_add_f32_e32 %0, %1, %2":"=v"(r):"v"(a),"v"(b));return r;}
__device__ __forceinline__ float fsub_s(float a,float b){float r;asm("v_sub_f32_e32 %0, %1, %2":"=v"(r):"v"(a),"v"(b));return r;}
typedef float f32x2_t __attribute__((ext_vector_type(2))); typedef __bf16 bf16x2_t __attribute__((ext_vector_type(2)));
__device__ __forceinline__ unsigned cvtpk_s(float lo,float hi){f32x2_t v={lo,hi};bf16x2_t b=__builtin_convertvector(v,bf16x2_t);return __builtin_bit_cast(unsigned,b);}
#define WAIT_BAR(N) asm volatile("s_waitcnt vmcnt(" #N ") lgkmcnt(0)\n\ts_barrier":::"memory")

__device__ __forceinline__ void qkt(f32x16&p0,f32x16&p1,const char*Kslot,const bf16x8*qr,const f32x16&negm,int r32,int hi){
  const char*kb=Kslot+hi*1024+r32*16;
  #pragma unroll
  for(int d0=0;d0<4;++d0){
    const bf16x8 b0=*reinterpret_cast<const bf16x8*>(kb+d0*2048);
    const bf16x8 b1=*reinterpret_cast<const bf16x8*>(kb+d0*2048+512);
    if(d0==0){p0=__builtin_amdgcn_mfma_f32_32x32x16_bf16(b0,qr[0],negm,0,0,0);p1=__builtin_amdgcn_mfma_f32_32x32x16_bf16(b1,qr[0],negm,0,0,0);}
    else{p0=__builtin_amdgcn_mfma_f32_32x32x16_bf16(b0,qr[d0],p0,0,0,0);p1=__builtin_amdgcn_mfma_f32_32x32x16_bf16(b1,qr[d0],p1,0,0,0);}}
}
typedef __attribute__((address_space(3))) const char* lds_cptr;
typedef short v4i16_t __attribute__((ext_vector_type(4)));
__device__ __forceinline__ void kload8(bf16x8*kf,lds_cptr kp){
  kf[0]=*(const __attribute__((address_space(3))) bf16x8*)(kp);      kf[1]=*(const __attribute__((address_space(3))) bf16x8*)(kp+512);
  kf[2]=*(const __attribute__((address_space(3))) bf16x8*)(kp+2048); kf[3]=*(const __attribute__((address_space(3))) bf16x8*)(kp+2560);
  kf[4]=*(const __attribute__((address_space(3))) bf16x8*)(kp+4096); kf[5]=*(const __attribute__((address_space(3))) bf16x8*)(kp+4608);
  kf[6]=*(const __attribute__((address_space(3))) bf16x8*)(kp+6144); kf[7]=*(const __attribute__((address_space(3))) bf16x8*)(kp+6656);
}
__device__ __forceinline__ void kload2(bf16x8*kf,lds_cptr kp,int j){ kf[2*j]=*(const __attribute__((address_space(3))) bf16x8*)(kp+j*2048); kf[2*j+1]=*(const __attribute__((address_space(3))) bf16x8*)(kp+j*2048+512); }
__device__ __forceinline__ s16x4 vtr(lds_cptr p){ return __builtin_bit_cast(s16x4,__builtin_amdgcn_ds_read_tr16_b64_v4i16((__attribute__((address_space(3))) v4i16_t*)p)); }
__device__ __forceinline__ float rowmax(const f32x16&p0,const f32x16&p1){
  float a=max3f(p0[0],p0[1],p1[0]),b=max3f(p0[2],p0[3],p1[1]);a=max3f(a,p1[2],p1[3]);
  #pragma unroll
  for(int r=4;r<16;r+=4){a=max3f(a,p0[r],p0[r+1]);b=max3f(b,p0[r+2],p0[r+3]);a=max3f(a,p1[r],p1[r+1]);b=max3f(b,p1[r+2],p1[r+3]);}
  const float m=max2f(a,b);
  auto rr=__builtin_amdgcn_permlane32_swap(__float_as_uint(m),__float_as_uint(m),false,false);
  return max2f(__uint_as_float(rr[0]),__uint_as_float(rr[1]));
}
__device__ __forceinline__ void pv(f32x16*o,int vb,bf16x8 pa0,bf16x8 pa1,bf16x8 pa2,bf16x8 pa3){
  #pragma unroll
  for(int d0=0;d0<2;++d0){s16x4 lo[4],hi[4];
    #pragma unroll
    for(int ks=0;ks<4;++ks){
      asm volatile("ds_read_b64_tr_b16 %0,%1 offset:%c2":"=&v"(lo[ks]):"v"(vb),"i"(d0*4096+ks*1024):"memory");
      asm volatile("ds_read_b64_tr_b16 %0,%1 offset:%c2":"=&v"(hi[ks]):"v"(vb),"i"(d0*4096+ks*1024+512):"memory");}
    asm volatile("s_waitcnt lgkmcnt(0)":::"memory");SBAR();
    #define PK(k) (bf16x8){lo[k][0],lo[k][1],lo[k][2],lo[k][3],hi[k][0],hi[k][1],hi[k][2],hi[k][3]}
    o[d0]=__builtin_amdgcn_mfma_f32_32x32x16_bf16(pa0,PK(0),o[d0],0,0,0);
    o[d0]=__builtin_amdgcn_mfma_f32_32x32x16_bf16(pa1,PK(1),o[d0],0,0,0);
    o[d0]=__builtin_amdgcn_mfma_f32_32x32x16_bf16(pa2,PK(2),o[d0],0,0,0);
    o[d0]=__builtin_amdgcn_mfma_f32_32x32x16_bf16(pa3,PK(3),o[d0],0,0,0);
    #undef PK
  }
}

#ifndef ATTN_STORE16
#define ATTN_STORE16(p,v) (*(u32x4*)(p)=(v))
#endif
template<int THRL> __device__ __forceinline__ void attn_unit(int b,int h,int qb,const bf16*Q,const bf16*__restrict__ K,const bf16*__restrict__ V,bf16*O,const float*ksum,const float*biasl2,char*shm){
  const int tid=threadIdx.x,lane=tid&63,r32=lane&31,hi=lane>>5; const int wid=__builtin_amdgcn_readfirstlane(tid>>6);
  const long rowbase=(long)b*SEQ; const int q0=qb*QB;
  const bf16*Qw=Q+(rowbase+q0+wid*QBLK)*DM+h*D;
  const bf16*Kh=K+rowbase*DM+h*D,*Vh=V+rowbase*DM+h*D;
  const unsigned lds0=(unsigned)(uintptr_t)shm;
  float*wsf=(float*)(shm+LDS_WS)+wid*64;
  const bf16*ksrc=Kh+(long)lane*DM+wid*8;
  const bf16*vsrc=Vh+(long)(16*(wid&3)+(lane>>2))*DM+(wid>>2)*32+(lane&3)*8;
  const unsigned kdst=lds0+LDS_K+wid*1024, vdst=lds0+LDS_V+wid*1024;
  #define KT(t) (((t)<4)?(NT-4+(t)):((t)-4))
  #define DMA_K(t,slot) glds16(ksrc+(long)KT(t)*KVBLK*DM,(unsigned)__builtin_amdgcn_readfirstlane(kdst+(slot)))
  #define DMA_V(t,slot) glds16(vsrc+(long)KT(t)*KVBLK*DM,(unsigned)__builtin_amdgcn_readfirstlane(vdst+(slot)))
  const int vb0=(int)(lds0+LDS_V)+((lane>>4)&1)*32+(lane&3)*8+(4*hi+((lane&15)>>2))*64;
  const char*Kbase=shm+LDS_K; bf16x8 kf[8];
  const lds_cptr shm3=(lds_cptr)shm; const lds_cptr kp0=shm3+LDS_K+hi*1024+r32*16; const lds_cptr vp0=shm3+LDS_V+((lane>>4)&1)*32+(lane&3)*8+(4*hi+((lane&15)>>2))*64;
  const int NT=(q0+QB)/KVBLK;
  { typedef __attribute__((address_space(3))) float* lds_fptr; const lds_fptr ext=(lds_fptr)((__attribute__((address_space(3))) char*)shm+LDS_LUT); const lds_fptr kms=(lds_fptr)((__attribute__((address_space(3))) char*)shm+LDS_KMS); const float*bh=biasl2+h*128;
    for(int i=tid;i<1024;i+=512){const int d=i-256; ext[i]=d<0?-INFINITY:bh[d<127?d:127];}
    kms[tid]=ksum[(long)(b*8+(tid>>6))*512+h*64+(tid&63)]; }
  const float bfar=biasl2[h*128+127];
  DMA_K(0,0);DMA_V(0,0);DMA_K(1,SLOTB);
  bf16x8 qr[4];
  #pragma unroll
  for(int d0=0;d0<4;++d0)qr[d0]=*reinterpret_cast<const bf16x8*>(&Qw[(long)r32*DM+d0*16+hi*8]);
  float mhat=0.f,l_reg=0.f;f32x16 o[2];o[0]=f32x16{};o[1]=f32x16{};
  const int qrel=wid*QBLK+r32;
  unsigned selmask=0u;
  const __attribute__((address_space(3))) float* lut3=(const __attribute__((address_space(3))) float*)(shm3+LDS_LUT);
  #define OFFR(r) (((r)&3)+8*((r)>>2))
  #define CMASK(P0,P1,t) do{ const int t_=(t); \
    if(t_>=4&&t_<NT-4){ const float fa_=(((selmask>>(((t_-4)>>2)&7))&1u)?bfar:-INFINITY)-mhat; \
      _Pragma("unroll") for(int r=0;r<16;++r){P0[r]+=fa_;P1[r]+=fa_;} } \
    else{ int bi_; if(t_<4)bi_=256+qrel-64*t_-4*hi-59; else bi_=((selmask>>(qb-1))&1u)?(512+qrel-64*(t_-(NT-4))-4*hi-59):0; \
      const __attribute__((address_space(3))) float* lp_=lut3+bi_; \
      _Pragma("unroll") for(int r=0;r<16;++r){P0[r]+=lp_[59-OFFR(r)];P1[r]+=lp_[27-OFFR(r)];} \
      _Pragma("unroll") for(int r=0;r<16;++r){P0[r]-=mhat;P1[r]-=mhat;} } }while(0)
  bool resc=false;
  #define START(P0,P1) do{ const float rm=rowmax(P0,P1); resc=false; \
    { const float dl=rm; mhat=fadd_s(mhat,dl); \
      _Pragma("unroll") for(int r=0;r<16;++r){P0[r]=fsub_s(P0[r],dl);P1[r]=fsub_s(P1[r],dl);} \
      } \
    _Pragma("unroll") for(int r=0;r<16;++r)P0[r]=__builtin_amdgcn_exp2f(P0[r]); }while(0)
  #define RESC() do{ if(resc){ asm volatile("s_waitcnt lgkmcnt(0)":::"memory"); \
      _Pragma("unroll") for(int d_=0;d_<2;++d_) _Pragma("unroll") for(int r=0;r<16;++r)o[d_][r]*=wsf[crow(r,hi)]; } }while(0)
  f32x16 pA0,pA1,pB0,pB1;
  int sl_prev=0,sl_cur=0,sl_next=SLOTB;
  #define ROT() do{sl_prev=sl_cur;sl_cur=sl_next;sl_next=(sl_next==(NSLOT-1)*SLOTB)?0:sl_next+SLOTB;}while(0)
  DMA_K(2,2*SLOTB);
  WAIT_BAR(3);
  { const __attribute__((address_space(3))) float* kms3=(const __attribute__((address_space(3))) float*)(shm3+LDS_KMS);
    float g[8];
    _Pragma("unroll") for(int j=0;j<8;++j){ float a=0.f;
      if(j<qb){
        _Pragma("unroll") for(int d0=0;d0<4;++d0){ const __attribute__((address_space(3))) float* kp_=kms3+j*64+16*d0+8*hi;
          _Pragma("unroll") for(int e=0;e<8;++e) a+=__builtin_bit_cast(float,((unsigned)(unsigned short)qr[d0][e])<<16)*kp_[e]; }
        a+=__shfl_xor(a,32); }
      g[j]=a; }
    if(qb<=3) selmask=(1u<<qb)-1u;
    else{ _Pragma("unroll") for(int rr=0;rr<3;++rr){ int best=-1; float bv=-INFINITY;
        _Pragma("unroll") for(int j=0;j<8;++j){ const bool ok=(j<qb)&&!((selmask>>j)&1u)&&(g[j]>bv); if(ok){bv=g[j];best=j;} }
        if(best>=0)selmask|=1u<<best; } } }
  qkt(pA0,pA1,Kbase,qr,f32x16{},r32,hi);asm volatile("s_nop 15\n\ts_nop 7":"+v"(pA0),"+v"(pA1));CMASK(pA0,pA1,0);
  START(pA0,pA1);
  _Pragma("unroll") for(int r=0;r<16;++r)pA1[r]=__builtin_amdgcn_exp2f(pA1[r]);
  WAIT_BAR(0);
  DMA_K(3,0);DMA_V(1,SLOTB);
  ROT();
  kload8(kf,kp0+sl_cur);
  WAIT_BAR(2);
  s16x4 vlo[8],vhi[8]; u32x4 pw0,pw1,pw2,pw3;
  #define PKW(P,B) cvtpk_s(P[B],P[B+1])
  #define PAF(k) __builtin_bit_cast(bf16x8,pw##k)
  #define VFR(i) (bf16x8){vlo[i][0],vlo[i][1],vlo[i][2],vlo[i][3],vhi[i][0],vhi[i][1],vhi[i][2],vhi[i][3]}
  #define PIN(x) asm volatile("":"+v"(x))
  #define MX3(a,b,c) __builtin_fmaxf(__builtin_fmaxf((a),(b)),(c))
  #define GAPA(MF,A0,A1,A2,A3,W0,W1,PW) do{ MF; sacc+=A0; sacc+=A1; sacc+=A2; sacc+=A3; PIN(sacc); W0; W1; PIN(PW); SBAR(); }while(0)
  #define EX(v) __builtin_amdgcn_exp2f(v)
  #define GAPB(MF,X,B) do{ MF; X[B]=EX(X[B]); X[B+1]=EX(X[B+1]); X[B+2]=EX(X[B+2]); X[B+3]=EX(X[B+3]); PIN(X); SBAR(); }while(0)
  #define VRD(i) do{ vlo[i]=vtr(vp_+(((i)>>2)*4096+((i)&3)*1024)); vhi[i]=vtr(vp_+(((i)>>2)*4096+((i)&3)*1024+512)); }while(0)
  #define KRD(G,j) do{ if(G){ kload2(kf,kp0+sl_next,j); SBAR(); } }while(0)
  #define STEP(C0,C1,P0,P1,t,GK,GV,GL) do{ SBAR(); \
    const lds_cptr vp_=vp0+sl_prev; \
    VRD(0); SBAR(); float sacc=(P0[0]+P0[1]); \
    GAPA(C0=__builtin_amdgcn_mfma_f32_32x32x16_bf16(kf[0],qr[0],f32x16{},0,0,0), P0[2],P0[3],P0[4],P0[5],     pw0[0]=PKW(P0,0), pw0[1]=PKW(P0,2), pw0); \
    VRD(4); SBAR(); GAPA(C1=__builtin_amdgcn_mfma_f32_32x32x16_bf16(kf[1],qr[0],f32x16{},0,0,0), P0[6],P0[7],P0[8],P0[9],     pw0[2]=PKW(P0,4), pw0[3]=PKW(P0,6), pw0); \
    VRD(1); SBAR(); GAPA(C0=__builtin_amdgcn_mfma_f32_32x32x16_bf16(kf[2],qr[1],C0,0,0,0),   P0[10],P0[11],P0[12],P0[13], pw1[0]=PKW(P0,8), pw1[1]=PKW(P0,10), pw1); \
    VRD(5); SBAR(); GAPA(C1=__builtin_amdgcn_mfma_f32_32x32x16_bf16(kf[3],qr[1],C1,0,0,0),   P0[14],P0[15],P1[0],P1[1],   pw1[2]=PKW(P0,12),pw1[3]=PKW(P0,14), pw1); \
    VRD(2); SBAR(); GAPA(C0=__builtin_amdgcn_mfma_f32_32x32x16_bf16(kf[4],qr[2],C0,0,0,0),   P1[2],P1[3],P1[4],P1[5],     pw2[0]=PKW(P1,0), pw2[1]=PKW(P1,2), pw2); \
    VRD(6); SBAR(); GAPA(C1=__builtin_amdgcn_mfma_f32_32x32x16_bf16(kf[5],qr[2],C1,0,0,0),   P1[6],P1[7],P1[8],P1[9],     pw2[2]=PKW(P1,4), pw2[3]=PKW(P1,6), pw2); \
    VRD(3); SBAR(); GAPA(C0=__builtin_amdgcn_mfma_f32_32x32x16_bf16(kf[6],qr[3],C0,0,0,0),   P1[10],P1[11],P1[12],P1[13], pw3[0]=PKW(P1,8), pw3[1]=PKW(P1,10), pw3); \
    VRD(7); SBAR(); GAPA(C1=__builtin_amdgcn_mfma_f32_32x32x16_bf16(kf[7],qr[3],C1,0,0,0),   P1[14],P1[15],0.f,0.f,       pw3[2]=PKW(P1,12),pw3[3]=PKW(P1,14), pw3); \
    l_reg+=sacc; \
    if(GK){DMA_K((t)+3,sl_cur);} if(GV){DMA_V((t)+1,sl_next);} \
    CMASK(C0,C1,t); \
    { float a=MX3(C0[0],C0[1],C1[0]),b=MX3(C0[2],C0[3],C1[1]); a=MX3(a,C1[2],C1[3]); \
      _Pragma("unroll") for(int r=4;r<16;r+=4){a=MX3(a,C0[r],C0[r+1]);b=MX3(b,C0[r+2],C0[r+3]);a=MX3(a,C1[r],C1[r+1]);b=MX3(b,C1[r+2],C1[r+3]);} \
      float rm=__builtin_fmaxf(a,b); { auto rr=__builtin_amdgcn_permlane32_swap(__float_as_uint(rm),__float_as_uint(rm),false,false); rm=__builtin_fmaxf(__uint_as_float(rr[0]),__uint_as_float(rr[1])); } \
      resc=false; \
      if(__builtin_expect(__any(rm>(float)THRL),0)){ const float dl=__builtin_fmaxf(rm,0.f); mhat+=dl; \
        _Pragma("unroll") for(int r=0;r<16;++r){C0[r]-=dl;C1[r]-=dl;} \
        const float f=__builtin_amdgcn_exp2f(-dl); l_reg*=f; if(hi==0)wsf[r32]=f; resc=true; } } \
    SBAR(); \
    GAPB(o[0]=__builtin_amdgcn_mfma_f32_32x32x16_bf16(PAF(0),VFR(0),o[0],0,0,0), C0,0); \
    GAPB(o[1]=__builtin_amdgcn_mfma_f32_32x32x16_bf16(PAF(0),VFR(4),o[1],0,0,0), C0,4); \
    KRD(GL,0); GAPB(o[0]=__builtin_amdgcn_mfma_f32_32x32x16_bf16(PAF(1),VFR(1),o[0],0,0,0), C0,8); \
    KRD(GL,1); GAPB(o[1]=__builtin_amdgcn_mfma_f32_32x32x16_bf16(PAF(1),VFR(5),o[1],0,0,0), C0,12); \
    KRD(GL,2); GAPB(o[0]=__builtin_amdgcn_mfma_f32_32x32x16_bf16(PAF(2),VFR(2),o[0],0,0,0), C1,0); \
    KRD(GL,3); GAPB(o[1]=__builtin_amdgcn_mfma_f32_32x32x16_bf16(PAF(2),VFR(6),o[1],0,0,0), C1,4); \
    GAPB(o[0]=__builtin_amdgcn_mfma_f32_32x32x16_bf16(PAF(3),VFR(3),o[0],0,0,0), C1,8); \
    GAPB(o[1]=__builtin_amdgcn_mfma_f32_32x32x16_bf16(PAF(3),VFR(7),o[1],0,0,0), C1,12); \
    }while(0)
  int t=1;
  for(;t+5<NT;t+=2){
    STEP(pB0,pB1,pA0,pA1,t,true,true,true);     WAIT_BAR(2); RESC(); ROT();
    STEP(pA0,pA1,pB0,pB1,t+1,true,true,true);   WAIT_BAR(2); RESC(); ROT();
  }
  #define ENDW(tt) do{ if((tt)+3<NT){WAIT_BAR(2);} else if((tt)+2<NT){WAIT_BAR(1);} else {WAIT_BAR(0);} }while(0)
  for(;t+1<NT;t+=2){
    STEP(pB0,pB1,pA0,pA1,t,(t+3<NT),(t+1<NT),(t+1<NT));       ENDW(t);   RESC(); ROT();
    STEP(pA0,pA1,pB0,pB1,t+1,(t+4<NT),(t+2<NT),(t+2<NT));     ENDW(t+1); RESC(); ROT();
  }
  STEP(pB0,pB1,pA0,pA1,NT-1,false,false,false); RESC();
  { float sacc=pB0[0]+pB0[1]; _Pragma("unroll") for(int r=2;r<16;++r)sacc+=pB0[r]; _Pragma("unroll") for(int r=0;r<16;++r)sacc+=pB1[r]; l_reg+=sacc;
    pw0=(u32x4){PKW(pB0,0),PKW(pB0,2),PKW(pB0,4),PKW(pB0,6)};pw1=(u32x4){PKW(pB0,8),PKW(pB0,10),PKW(pB0,12),PKW(pB0,14)};pw2=(u32x4){PKW(pB1,0),PKW(pB1,2),PKW(pB1,4),PKW(pB1,6)};pw3=(u32x4){PKW(pB1,8),PKW(pB1,10),PKW(pB1,12),PKW(pB1,14)};
    SBAR(); pv(o,vb0+sl_cur,PAF(0),PAF(1),PAF(2),PAF(3)); }
  #undef PKW
  #undef PAF
  #undef VFR
  #undef PIN
  #undef MX3
  #undef GAPA
  #undef GAPB
  #undef EX
  #undef VRD
  #undef KRD
  #undef STEP
  #undef ENDW
  {auto rr=__builtin_amdgcn_permlane32_swap(__float_as_uint(l_reg),__float_as_uint(l_reg),false,false);l_reg=__uint_as_float(rr[0])+__uint_as_float(rr[1]);}
  if(hi==0)wsf[32+r32]=l_reg;asm volatile("s_waitcnt lgkmcnt(0)":::"memory");
  float rli[16];
  #pragma unroll
  for(int r=0;r<16;++r)rli[r]=__builtin_amdgcn_rcpf(wsf[32+crow(r,hi)]);
  bf16*Ow=O+(rowbase+q0+wid*QBLK)*OPITCH+h*D;
  { bf16*stg=(bf16*)(shm+LDS_OST)+wid*2048;
    #pragma unroll
    for(int r=0;r<16;++r){const int orow=crow(r,hi);
      #pragma unroll
      for(int d0=0;d0<2;++d0)stg[orow*64+d0*32+r32]=__float2bfloat16(o[d0][r]*rli[r]);}
    asm volatile("s_waitcnt lgkmcnt(0)":::"memory");
    #pragma unroll
    for(int i=0;i<4;++i){const int row=i*8+(lane>>3),ch=lane&7; const u32x4 v=*(const u32x4*)(stg+row*64+ch*8); ATTN_STORE16(Ow+(long)row*OPITCH+ch*8,v);} }
  asm volatile("s_waitcnt lgkmcnt(0)\n\ts_barrier":::"memory");
  #undef DMA_K
  #undef DMA_V
  #undef KT
  #undef OFFR
  #undef CMASK
  #undef START
  #undef RESC
  #undef ROT
}
constexpr int ATTN_LDS_BYTES=LDS_BYTES;
struct AttnTensors { const bf16* Q; const bf16* K; const bf16* V; bf16* O; const float* ksum; const float* biasl2; };
struct AttnUnit { int bh; int qb; };
struct StaticOrder {
  int vcu;
  __device__ __forceinline__ explicit StaticOrder(int grid,int block):vcu((block%8)*(grid/8)+block/8){}
  __device__ __forceinline__ bool next(int i,AttnUnit&u)const{ if(i>=4||vcu>=256)return false; const int p=vcu&1; u.bh=vcu>>1; u.qb=(i==0)?7-p:(i==1)?p:(i==2)?4+p:3-p; return true; }
  __device__ __forceinline__ void a_ready(const AttnUnit&)const{}
  __device__ __forceinline__ void done(const AttnUnit&)const{}
};
template<class Sched,int THRL=8> __device__ __forceinline__ void attn_phase(char*lds,const AttnTensors&T,const Sched&S){
  AttnUnit u;
  for(int i=0;S.next(i,u);++i){ S.a_ready(u); attn_unit<THRL>(u.bh/NHEAD,u.bh%NHEAD,u.qb,T.Q,T.K,T.V,T.O,T.ksum,T.biasl2,lds); S.done(u); }
}
#undef SBAR
#undef WAIT_BAR
}
namespace attn_body {
namespace xa {
constexpr int XP=1024, XSLOT=32768, X_RING=0, X_OST=2*XSLOT, X_WS=X_OST+NW*4096, X_LDS_BYTES=X_WS+NW*256;
#define XWAITBAR(N) asm volatile("s_waitcnt vmcnt(" #N ") lgkmcnt(0)\n\ts_barrier":::"memory")
#define XBAR() asm volatile("s_waitcnt lgkmcnt(0)\n\ts_barrier":::"memory")
__device__ __forceinline__ void xattn_unit(int b,int h,int qb,const bf16*Q,const bf16*__restrict__ K,const bf16*__restrict__ V,bf16*O,char*shm){
  const int tid=threadIdx.x,lane=tid&63,r32=lane&31,hi=lane>>5; const int wid=__builtin_amdgcn_readfirstlane(tid>>6);
  const long qrow0=(long)b*2048+qb*256+wid*32; const long krow0=(long)b*256;
  const bf16*Qw=Q+qrow0*XP+h*256;
  const bf16*Kh=K+krow0*XP+h*256,*Vh=V+krow0*XP+h*256;
  const unsigned lds0=(unsigned)(uintptr_t)shm;
  const bf16*ksrc=Kh+(long)lane*XP+wid*8;
  const bf16*vsrc=Vh+(long)(16*(wid&3)+(lane>>2))*XP+(wid>>2)*32+(lane&3)*8;
  const unsigned kdst=lds0+X_RING+wid*1024;
  #define XDMA_K(t,slot) do{ _Pragma("unroll") for(int g_=0;g_<4;++g_) glds16(ksrc+(long)(t)*64*XP+g_*64,(unsigned)__builtin_amdgcn_readfirstlane(kdst+(slot)*XSLOT+g_*8192)); }while(0)
  #define XDMA_V(t,slot) do{ _Pragma("unroll") for(int g_=0;g_<4;++g_) glds16(vsrc+(long)(t)*64*XP+g_*64,(unsigned)__builtin_amdgcn_readfirstlane(kdst+(slot)*XSLOT+g_*8192)); }while(0)
  const lds_cptr shm3=(lds_cptr)shm;
  const lds_cptr kp0=shm3+X_RING+hi*1024+r32*16;
  const lds_cptr vp0=shm3+X_RING+((lane>>4)&1)*32+(lane&3)*8+(4*hi+((lane&15)>>2))*64;
  bf16x8 qr[16];
  #pragma unroll
  for(int i=0;i<16;++i)qr[i]=*reinterpret_cast<const bf16x8*>(&Qw[(long)r32*XP+i*16+hi*8]);
  asm volatile("":::"memory");
  XDMA_K(0,0); XDMA_K(1,1);
  f32x16 s[8];
  #define XQK(t,slot) do{ const lds_cptr kb_=kp0+(slot)*XSLOT; f32x16 c0_=f32x16{},c1_=f32x16{}; \
    _Pragma("unroll") for(int g_=0;g_<4;++g_) _Pragma("unroll") for(int d0=0;d0<4;++d0){ \
      const bf16x8 b0_=*(const __attribute__((address_space(3))) bf16x8*)(kb_+g_*8192+d0*2048); \
      const bf16x8 b1_=*(const __attribute__((address_space(3))) bf16x8*)(kb_+g_*8192+d0*2048+512); \
      c0_=__builtin_amdgcn_mfma_f32_32x32x16_bf16(b0_,qr[g_*4+d0],c0_,0,0,0); c1_=__builtin_amdgcn_mfma_f32_32x32x16_bf16(b1_,qr[g_*4+d0],c1_,0,0,0);} \
    s[2*(t)]=c0_; s[2*(t)+1]=c1_; }while(0)
  XWAITBAR(4); XQK(0,0); XBAR(); XDMA_K(2,0);
  XWAITBAR(4); XQK(1,1); XBAR(); XDMA_K(3,1);
  XWAITBAR(4); XQK(2,0); XBAR(); XDMA_V(0,0);
  XWAITBAR(4); XQK(3,1); XBAR(); XDMA_V(1,1);
  float mx=s[0][0];
  #pragma unroll
  for(int t=0;t<8;++t)
    #pragma unroll
    for(int r=0;r<16;++r)mx=__builtin_fmaxf(mx,s[t][r]);
  { auto rr=__builtin_amdgcn_permlane32_swap(__float_as_uint(mx),__float_as_uint(mx),false,false); mx=__builtin_fmaxf(__uint_as_float(rr[0]),__uint_as_float(rr[1])); }
  float l=0.f;
  #pragma unroll
  for(int t=0;t<8;++t)
    #pragma unroll
    for(int r=0;r<16;++r){ s[t][r]=__builtin_amdgcn_exp2f(s[t][r]-mx); l+=s[t][r]; }
  { auto rr=__builtin_amdgcn_permlane32_swap(__float_as_uint(l),__float_as_uint(l),false,false); l=__uint_as_float(rr[0])+__uint_as_float(rr[1]); }
  u32x4 pw[16];
  #pragma unroll
  for(int t=0;t<4;++t){
    pw[4*t+0]=(u32x4){cvtpk_s(s[2*t][0],s[2*t][1]),cvtpk_s(s[2*t][2],s[2*t][3]),cvtpk_s(s[2*t][4],s[2*t][5]),cvtpk_s(s[2*t][6],s[2*t][7])};
    pw[4*t+1]=(u32x4){cvtpk_s(s[2*t][8],s[2*t][9]),cvtpk_s(s[2*t][10],s[2*t][11]),cvtpk_s(s[2*t][12],s[2*t][13]),cvtpk_s(s[2*t][14],s[2*t][15])};
    pw[4*t+2]=(u32x4){cvtpk_s(s[2*t+1][0],s[2*t+1][1]),cvtpk_s(s[2*t+1][2],s[2*t+1][3]),cvtpk_s(s[2*t+1][4],s[2*t+1][5]),cvtpk_s(s[2*t+1][6],s[2*t+1][7])};
    pw[4*t+3]=(u32x4){cvtpk_s(s[2*t+1][8],s[2*t+1][9]),cvtpk_s(s[2*t+1][10],s[2*t+1][11]),cvtpk_s(s[2*t+1][12],s[2*t+1][13]),cvtpk_s(s[2*t+1][14],s[2*t+1][15])}; }
  f32x16 o[8];
  #pragma unroll
  for(int i=0;i<8;++i)o[i]=f32x16{};
  #define XPV(t,slot) do{ const lds_cptr vb_=vp0+(slot)*XSLOT; \
    _Pragma("unroll") for(int g_=0;g_<4;++g_) _Pragma("unroll") for(int d0=0;d0<2;++d0){ s16x4 lo_[4],hi_[4]; \
      _Pragma("unroll") for(int ks=0;ks<4;++ks){ lo_[ks]=vtr(vb_+g_*8192+d0*4096+ks*1024); hi_[ks]=vtr(vb_+g_*8192+d0*4096+ks*1024+512); } \
      _Pragma("unroll") for(int ks=0;ks<4;++ks) o[g_*2+d0]=__builtin_amdgcn_mfma_f32_32x32x16_bf16(__builtin_bit_cast(bf16x8,pw[4*(t)+ks]), \
          (bf16x8){lo_[ks][0],lo_[ks][1],lo_[ks][2],lo_[ks][3],hi_[ks][0],hi_[ks][1],hi_[ks][2],hi_[ks][3]},o[g_*2+d0],0,0,0); } }while(0)
  XWAITBAR(4); XPV(0,0); XBAR(); XDMA_V(2,0);
  XWAITBAR(4); XPV(1,1); XBAR(); XDMA_V(3,1);
  XWAITBAR(4); XPV(2,0); XBAR();
  XWAITBAR(0); XPV(3,1); XBAR();
  float*wsf=(float*)(shm+X_WS)+wid*64;
  if(hi==0)wsf[r32]=l; asm volatile("s_waitcnt lgkmcnt(0)":::"memory");
  float rli[16];
  #pragma unroll
  for(int r=0;r<16;++r)rli[r]=__builtin_amdgcn_rcpf(wsf[crow(r,hi)]);
  bf16*Ow=O+qrow0*XP+h*256;
  bf16*stg=(bf16*)(shm+X_OST)+wid*2048;
  #pragma unroll
  for(int g=0;g<4;++g){
    #pragma unroll
    for(int r=0;r<16;++r){const int orow=crow(r,hi);
      #pragma unroll
      for(int d0=0;d0<2;++d0)stg[orow*64+d0*32+r32]=__float2bfloat16(o[g*2+d0][r]*rli[r]);}
    asm volatile("s_waitcnt lgkmcnt(0)":::"memory");
    #pragma unroll
    for(int i=0;i<4;++i){const int row=i*8+(lane>>3),ch=lane&7; const u32x4 v=*(const u32x4*)(stg+row*64+ch*8); *(u32x4*)(Ow+(long)row*XP+g*64+ch*8)=v;}
    asm volatile("s_waitcnt lgkmcnt(0)":::"memory");
  }
  asm volatile("s_waitcnt vmcnt(0) lgkmcnt(0)\n\ts_barrier":::"memory");
  #undef XDMA_K
  #undef XDMA_V
  #undef XQK
  #undef XPV
}
__device__ __forceinline__ void xattn_phase(char*lds,const bf16*Q,const bf16*K,const bf16*V,bf16*O,int grid,int block){
  const int vcu=(block%8)*(grid/8)+block/8; if(vcu>=256)return;
  const int bh=vcu>>2;
  for(int i=0;i<2;++i) xattn_unit(bh>>2,bh&3,2*(vcu&3)+i,Q,K,V,O,lds);
}
#undef XWAITBAR
#undef XBAR
}
}
namespace attn_body {
namespace gla {
typedef __attribute__((address_space(3))) char* lptr;
typedef __attribute__((address_space(3))) float* lfptr;
typedef float f32x4v __attribute__((ext_vector_type(4)));
typedef float f32x2v __attribute__((ext_vector_type(2)));
typedef unsigned u32x2v __attribute__((ext_vector_type(2)));
constexpr int GP=144;
constexpr int L_WG=0, L_BG=16384, L_QE=17408, L_KE=L_QE+64*GP, L_KLT=L_KE+64*GP, L_V=49152, L_P1_BYTES=L_V+16384;
constexpr int OBP=132;
__device__ __forceinline__ float bfv(short s){return __builtin_bit_cast(float,((unsigned)(unsigned short)s)<<16);}
__device__ __forceinline__ unsigned short f2b(float f){ return (unsigned short)(cvtpk_s(f,0.f)&0xffffu); }

__device__ __forceinline__ void gla_pass1(char*shm,int grid,int block,const bf16*QG_,const bf16*KG_,const bf16*VG_,const float*GLR,const float*wgu,const float*bgate,
                                          bf16*QE_,float*DEC,float*GU,float*GOI){
  const unsigned short*QG=(const unsigned short*)QG_; const unsigned short*KG=(const unsigned short*)KG_; const unsigned short*VG=(const unsigned short*)VG_; unsigned short*QE=(unsigned short*)QE_;
  const int tid=threadIdx.x,lane=tid&63,r32=lane&31,h=lane>>5; const int w=__builtin_amdgcn_readfirstlane(tid>>6);
  const lptr sh=(lptr)shm;
  { const lfptr wl=(lfptr)(sh+L_WG); const lfptr bl=(lfptr)(sh+L_BG);
    for(int i=tid;i<16*256;i+=512) wl[i]=wgu[i];
    if(tid<256) bl[tid]=bgate[tid]; }
  const int hh=w&1,vq=w>>1;
  const int c16=(lane>>4)&1,qq=(lane&15)>>2,pp=lane&3;
  const int vcol=(vq>>1)*8192+(vq&1)*4096+(16*c16+4*pp)*2;
  const int vnat=vcol+(8*h+qq)*64, vper=vcol+(4*h+qq)*64;
  for(int it=0;it<8;++it){
    const int uid=it*grid+block; if(uid>=2048)break;
    const int chain=uid>>5,c=uid&31,b=chain>>2,hg=chain&3; const long r0=(long)b*2048+c*64;
    asm volatile("s_waitcnt lgkmcnt(0)\n\ts_barrier":::"memory");
    { const long row=r0+lane;
      f32x4v gl4[4];
      #pragma unroll
      for(int i=0;i<4;++i)gl4[i]=*(const f32x4v*)(GLR+row*16+4*i);
      const bf16x8 q8=*(const bf16x8*)(QG+row*256+hg*64+8*w), k8=*(const bf16x8*)(KG+row*256+hg*64+8*w);
      #pragma unroll
      for(int i=0;i<2;++i){ const int e=tid+512*i, vr=e>>4, d8=(e&15)*8;
        const u32x4 vv=*(const u32x4*)(VG+(r0+vr)*512+hg*128+d8);
        *(__attribute__((address_space(3))) u32x4*)(sh+L_V+(d8>>6)*8192+((d8>>5)&1)*4096+(vr>>4)*1024+(vr&15)*64+(d8&31)*2)=vv; }
      float z[8];
      { const lfptr bl=(lfptr)(sh+L_BG);
        #pragma unroll
        for(int j=0;j<8;++j)z[j]=bl[hg*64+8*w+j]; }
      #pragma unroll
      for(int r=0;r<16;++r){ const float gv=gl4[r>>2][r&3]; const lfptr wl=(lfptr)(sh+L_WG)+r*256+hg*64+8*w;
        const f32x4v w0=*(__attribute__((address_space(3))) f32x4v*)wl, w1=*(__attribute__((address_space(3))) f32x4v*)(wl+4);
        z[0]+=gv*w0[0];z[1]+=gv*w0[1];z[2]+=gv*w0[2];z[3]+=gv*w0[3];z[4]+=gv*w1[0];z[5]+=gv*w1[1];z[6]+=gv*w1[2];z[7]+=gv*w1[3]; }
      float bc[8],bl_[8];
      #pragma unroll
      for(int j=0;j<8;++j){ const float zz=z[j]; float v=(fminf(zz,0.f)-__logf(1.f+__expf(-fabsf(zz))))*0.0625f;
        #pragma unroll
        for(int d=1;d<64;d<<=1){ const float u=__shfl_up(v,d); if(lane>=d)v+=u; }
        bc[j]=v; bl_[j]=__shfl(v,63); }
      unsigned short qe[8],ke[8];
      __attribute__((address_space(3))) unsigned short* kltp=(__attribute__((address_space(3))) unsigned short*)(sh+L_KLT);
      #pragma unroll
      for(int j=0;j<8;++j){ const float kv=bfv(k8[j]);
        qe[j]=f2b(bfv(q8[j])*__expf(bc[j])); ke[j]=f2b(kv*__expf(-bc[j]));
        kltp[(8*w+j)*(GP/2)+lane]=f2b(kv*__expf(bl_[j]-bc[j])); }
      const u32x4 qv=(u32x4){(unsigned)qe[0]|((unsigned)qe[1]<<16),(unsigned)qe[2]|((unsigned)qe[3]<<16),(unsigned)qe[4]|((unsigned)qe[5]<<16),(unsigned)qe[6]|((unsigned)qe[7]<<16)};
      const u32x4 kvv=(u32x4){(unsigned)ke[0]|((unsigned)ke[1]<<16),(unsigned)ke[2]|((unsigned)ke[3]<<16),(unsigned)ke[4]|((unsigned)ke[5]<<16),(unsigned)ke[6]|((unsigned)ke[7]<<16)};
      *(__attribute__((address_space(3))) u32x4*)(sh+L_QE+lane*GP+16*w)=qv;
      *(__attribute__((address_space(3))) u32x4*)(sh+L_KE+lane*GP+16*w)=kvv;
      *(u32x4*)(QE+row*256+hg*64+8*w)=qv;
      if(lane==0){ float*dp=DEC+(long)uid*64+8*w;
        *(f32x4v*)dp=(f32x4v){__expf(bl_[0]),__expf(bl_[1]),__expf(bl_[2]),__expf(bl_[3])}; *(f32x4v*)(dp+4)=(f32x4v){__expf(bl_[4]),__expf(bl_[5]),__expf(bl_[6]),__expf(bl_[7])}; }
    }
    asm volatile("s_waitcnt lgkmcnt(0)\n\ts_barrier":::"memory");
    { const lds_cptr shc=(lds_cptr)shm;
      f32x16 u=f32x16{};
      #pragma unroll
      for(int s=0;s<4;++s){
        const bf16x8 a=*(const __attribute__((address_space(3))) bf16x8*)(shc+L_KLT+(32*hh+r32)*GP+(16*s+8*h)*2);
        const s16x4 lo=vtr(shc+L_V+vnat+s*1024), hi_=vtr(shc+L_V+vnat+s*1024+256);
        u=__builtin_amdgcn_mfma_f32_32x32x16_bf16(a,(bf16x8){lo[0],lo[1],lo[2],lo[3],hi_[0],hi_[1],hi_[2],hi_[3]},u,0,0,0); }
      f32x16 o=f32x16{};
      #pragma unroll
      for(int a=0;a<2;++a){ if(a<=hh){
        f32x16 at=f32x16{};
        #pragma unroll
        for(int s=0;s<4;++s){
          const bf16x8 ka=*(const __attribute__((address_space(3))) bf16x8*)(shc+L_KE+(32*a+r32)*GP+(16*s+8*h)*2);
          const bf16x8 qb=*(const __attribute__((address_space(3))) bf16x8*)(shc+L_QE+(32*hh+r32)*GP+(16*s+8*h)*2);
          at=__builtin_amdgcn_mfma_f32_32x32x16_bf16(ka,qb,at,0,0,0); }
        if(a==hh){
          #pragma unroll
          for(int r=0;r<16;++r) if(crow(r,h)>r32) at[r]=0.f; }
        const u32x4 p0=(u32x4){cvtpk_s(at[0],at[1]),cvtpk_s(at[2],at[3]),cvtpk_s(at[4],at[5]),cvtpk_s(at[6],at[7])};
        const u32x4 p1=(u32x4){cvtpk_s(at[8],at[9]),cvtpk_s(at[10],at[11]),cvtpk_s(at[12],at[13]),cvtpk_s(at[14],at[15])};
        { const s16x4 lo=vtr(shc+L_V+vper+(2*a)*1024), hi_=vtr(shc+L_V+vper+(2*a)*1024+512);
          o=__builtin_amdgcn_mfma_f32_32x32x16_bf16(__builtin_bit_cast(bf16x8,p0),(bf16x8){lo[0],lo[1],lo[2],lo[3],hi_[0],hi_[1],hi_[2],hi_[3]},o,0,0,0); }
        { const s16x4 lo=vtr(shc+L_V+vper+(2*a+1)*1024), hi_=vtr(shc+L_V+vper+(2*a+1)*1024+512);
          o=__builtin_amdgcn_mfma_f32_32x32x16_bf16(__builtin_bit_cast(bf16x8,p1),(bf16x8){lo[0],lo[1],lo[2],lo[3],hi_[0],hi_[1],hi_[2],hi_[3]},o,0,0,0); }
      } }
      float*up=GU+(long)uid*8192+(hh*4+vq)*1024+lane*4; float*op=GOI+(long)uid*8192+(hh*4+vq)*1024+lane*4;
      #pragma unroll
      for(int g=0;g<4;++g){ *(f32x4v*)(up+g*256)=(f32x4v){u[4*g],u[4*g+1],u[4*g+2],u[4*g+3]}; *(f32x4v*)(op+g*256)=(f32x4v){o[4*g],o[4*g+1],o[4*g+2],o[4*g+3]}; }
    }
  }
  asm volatile("s_waitcnt lgkmcnt(0)\n\ts_barrier":::"memory");
}

struct ChainLoad { u32x4 u0[4],u1[4],d0[4],d1[4],oi[4]; u32x2v qa[8]; };
__device__ __forceinline__ void gla_chain(char*shm,int chain,const bf16*QE_,const float*DEC,const float*GU,const float*GOI,const bf16*RG_,const float*gnorm,bf16*MIX_){
  const int tid=threadIdx.x,lane=tid&63,r32=lane&31,h=lane>>5; const int w=__builtin_amdgcn_readfirstlane(tid>>6);
  const int hh=w&1,vq=w>>1,b=chain>>2,hg=chain&3;
  const __amdgpu_buffer_rsrc_t rU=__builtin_amdgcn_make_buffer_rsrc((void*)(GU+(long)chain*32*8192),0,32*8192*4,0x00020000);
  const __amdgpu_buffer_rsrc_t rO=__builtin_amdgcn_make_buffer_rsrc((void*)(GOI+(long)chain*32*8192),0,32*8192*4,0x00020000);
  const __amdgpu_buffer_rsrc_t rD=__builtin_amdgcn_make_buffer_rsrc((void*)(DEC+(long)chain*32*64),0,32*64*4,0x00020000);
  const __amdgpu_buffer_rsrc_t rQ=__builtin_amdgcn_make_buffer_rsrc((void*)((const unsigned short*)QE_+(long)b*2048*256),0,2048*256*2,0x00020000);
  const __amdgpu_buffer_rsrc_t rR=__builtin_amdgcn_make_buffer_rsrc((void*)((const unsigned short*)RG_+(long)b*2048*512),0,2048*512*2,0x00020000);
  const __amdgpu_buffer_rsrc_t rM=__builtin_amdgcn_make_buffer_rsrc((void*)((unsigned short*)MIX_+(long)b*2048*1024),0,2048*1024*2,0x00020000);
  const int voU=(vq*1024+lane*4)*4, voO=((hh*4+vq)*1024+lane*4)*4, voD=16*h, voQ=((32*hh+r32)*256+hg*64+4*h)*2, voR=hg*256+lane*4, voM=(512+hg*128)*2+lane*4;
  const lfptr ob=(lfptr)((lptr)shm);
  f32x16 S0=f32x16{},S1=f32x16{};
  const float gn0=gnorm[2*lane],gn1=gnorm[2*lane+1];
  #define CH_LOAD(L,cc) do{ const int sU_=(cc)*32768, sD_=(cc)*256, sQ_=(cc)*32768; \
    _Pragma("unroll") for(int g=0;g<4;++g){ L.u0[g]=__builtin_amdgcn_raw_buffer_load_b128(rU,voU+g*1024,sU_,0); L.u1[g]=__builtin_amdgcn_raw_buffer_load_b128(rU,voU+g*1024,sU_+16384,0); \
      L.oi[g]=__builtin_amdgcn_raw_buffer_load_b128(rO,voO+g*1024,sU_,0); L.d0[g]=__builtin_amdgcn_raw_buffer_load_b128(rD,voD+32*g,sD_,0); L.d1[g]=__builtin_amdgcn_raw_buffer_load_b128(rD,voD+128+32*g,sD_,0); } \
    _Pragma("unroll") for(int k=0;k<4;++k){ L.qa[2*k]=__builtin_amdgcn_raw_buffer_load_b64(rQ,voQ+32*k,sQ_,0); L.qa[2*k+1]=__builtin_amdgcn_raw_buffer_load_b64(rQ,voQ+32*k+16,sQ_,0); } }while(0)
  ChainLoad A; CH_LOAD(A,0);
  #pragma unroll 1
  for(int c=0;c<32;++c){
    unsigned rgv[8];
    #pragma unroll
    for(int i=0;i<8;++i) rgv[i]=__builtin_amdgcn_raw_buffer_load_b32(rR,voR,(c*64+8*w+i)*1024,0);
    f32x16 o;
    #pragma unroll
    for(int g=0;g<4;++g){ const f32x4v t4=__builtin_bit_cast(f32x4v,A.oi[g]); o[4*g]=t4[0];o[4*g+1]=t4[1];o[4*g+2]=t4[2];o[4*g+3]=t4[3]; }
    #pragma unroll
    for(int k=0;k<4;++k){ const int dh=k>>1,s=k&1;
      u32x4 bw;
      if(dh==0) bw=(u32x4){cvtpk_s(S0[8*s],S0[8*s+1]),cvtpk_s(S0[8*s+2],S0[8*s+3]),cvtpk_s(S0[8*s+4],S0[8*s+5]),cvtpk_s(S0[8*s+6],S0[8*s+7])};
      else      bw=(u32x4){cvtpk_s(S1[8*s],S1[8*s+1]),cvtpk_s(S1[8*s+2],S1[8*s+3]),cvtpk_s(S1[8*s+4],S1[8*s+5]),cvtpk_s(S1[8*s+6],S1[8*s+7])};
      const u32x4 aw=(u32x4){A.qa[2*k][0],A.qa[2*k][1],A.qa[2*k+1][0],A.qa[2*k+1][1]};
      o=__builtin_amdgcn_mfma_f32_32x32x16_bf16(__builtin_bit_cast(bf16x8,aw),__builtin_bit_cast(bf16x8,bw),o,0,0,0); }
    #pragma unroll
    for(int g=0;g<4;++g){ const f32x4v d0=__builtin_bit_cast(f32x4v,A.d0[g]),d1=__builtin_bit_cast(f32x4v,A.d1[g]),u0=__builtin_bit_cast(f32x4v,A.u0[g]),u1=__builtin_bit_cast(f32x4v,A.u1[g]);
      #pragma unroll
      for(int e=0;e<4;++e){ S0[4*g+e]=S0[4*g+e]*d0[e]+u0[e]; S1[4*g+e]=S1[4*g+e]*d1[e]+u1[e]; } }
    if(c+1<32){ CH_LOAD(A,c+1); }
    const lfptr obc=ob+(c&1)*64*OBP;
    #pragma unroll
    for(int r=0;r<16;++r) obc[(32*hh+crow(r,h))*OBP+32*vq+r32]=o[r];
    asm volatile("s_waitcnt lgkmcnt(0)\n\ts_barrier":::"memory");
    #pragma unroll
    for(int i=0;i<8;++i){ const int t=8*w+i; const f32x2v vv=*(const __attribute__((address_space(3))) f32x2v*)(obc+t*OBP+2*lane); const float v0=vv[0],v1=vv[1];
      float ss=v0*v0+v1*v1;
      #pragma unroll
      for(int d=1;d<64;d<<=1)ss+=__shfl_xor(ss,d);
      const float rstd=__builtin_amdgcn_rsqf(ss*(1.f/128.f)+1e-6f);
      const float g0=__builtin_bit_cast(float,rgv[i]<<16),g1=__builtin_bit_cast(float,rgv[i]&0xffff0000u);
      const float y0=v0*rstd*gn0*(g0/(1.f+__expf(-g0))), y1=v1*rstd*gn1*(g1/(1.f+__expf(-g1)));
      __builtin_amdgcn_raw_buffer_store_b32(cvtpk_s(y0,y1),rM,voM,(c*64+t)*2048,0); }
  }
  #undef CH_LOAD
  asm volatile("s_waitcnt vmcnt(0) lgkmcnt(0)\n\ts_barrier":::"memory");
}
}
}
#define PG8_SP2 true
#define PG8_ALIGN true

constexpr int NWAVES = 8;
constexpr int BATCH = 16, SEQ = 2048, DM = 1024, M = BATCH * SEQ;
constexpr int MEMLEN = 256, MM = BATCH * MEMLEN;
constexpr int AH = 8, AHD = 64, AW = 512, NBLK = SEQ / 256;
constexpr int GH = 4, GHK = 64, GHV = 128, GKW = 256, GW = 512, GRANK = 16;
constexpr int XH = 4, XHD = 256;
constexpr int FF = 4096;
constexpr int NIN = 3328;
constexpr float EPS = 1e-6f;
constexpr float LOG2E = 1.4426950408889634f;
constexpr float C2A = 0.125f * LOG2E;
constexpr float C2X = 0.0625f * LOG2E;

constexpr size_t MiB = 1u << 20;
constexpr size_t WS_CTL = 0, CTL_ZERO_BYTES = 256 * 1024;
constexpr size_t WS_SSQ1 = 1 * MiB, WS_SSQ2 = WS_SSQ1 + 128 * 1024, WS_SSQ3 = WS_SSQ2 + 128 * 1024;
constexpr size_t WS_KSUM = WS_SSQ3 + 128 * 1024;
constexpr size_t WS_BIAS = WS_KSUM + 256 * 1024;
constexpr size_t WS_SSQD = WS_BIAS + 64 * 1024;
constexpr size_t WS_WIN = 2 * MiB, WS_WOUT = 9 * MiB, WS_WXQ = 11 * MiB, WS_WXKV = 13 * MiB, WS_WXO = 17 * MiB, WS_WUP = 19 * MiB, WS_WDN = 27 * MiB;
constexpr size_t WS_GLR = 36 * MiB;
constexpr size_t WS_MN = 38 * MiB, WS_KX = 46 * MiB, WS_VX = 54 * MiB;
constexpr size_t WS_HA = 64 * MiB;
constexpr size_t WS_MIX = 128 * MiB;
constexpr size_t WS_QA = 192 * MiB, WS_KA = 224 * MiB, WS_VA = 256 * MiB, WS_QG = 288 * MiB, WS_KG = 304 * MiB, WS_VG = 320 * MiB, WS_RG = 352 * MiB;
constexpr size_t WS_QX = 192 * MiB, WS_OX = 256 * MiB;
constexpr size_t WS_U = 192 * MiB;
constexpr size_t WS_QE = 384 * MiB, WS_DEC = 400 * MiB;
constexpr size_t WS_END = 448 * MiB;
constexpr int CW_Q = 512;
constexpr int CW_BAR = 1024;

constexpr int RING_OFF = 0, RING_BYTES = 131072;
constexpr int LDSCTL_OFF = RING_BYTES, MISC_OFF = LDSCTL_OFF + 320;
constexpr int LDS_BYTES = 147456;
#define GAS __attribute__((address_space(1)))
#define LAS __attribute__((address_space(3)))
typedef unsigned short bf16;
typedef unsigned v4u __attribute__((ext_vector_type(4)));
typedef float f32x4 __attribute__((ext_vector_type(4)));
typedef short bf16x8 __attribute__((ext_vector_type(8)));
typedef GAS unsigned gu32;
typedef GAS unsigned long long gu64;
#define RLX_AGENT __ATOMIC_RELAXED, __HIP_MEMORY_SCOPE_AGENT
#define LDS_WAIT() asm volatile("s_waitcnt lgkmcnt(0)" ::: "memory")
#define VM_WAIT() asm volatile("s_waitcnt vmcnt(0)" ::: "memory")
__device__ __forceinline__ unsigned long long rt() { return __builtin_amdgcn_s_memrealtime(); }
__device__ __forceinline__ unsigned f2bf(float f) { unsigned u = __builtin_bit_cast(unsigned, f); return (u + 0x7fffu + ((u >> 16) & 1u)) >> 16; }
__device__ __forceinline__ unsigned pk2(float lo, float hi) { return f2bf(lo) | (f2bf(hi) << 16); }
#define XB_TMO      128
#define XB_XCNT(j)  (256  + 64 * (j))
#define XB_XSUB(j)  (1280 + 64 * (j))
#define XB_XGEN(j)  (2304 + 64 * (j))
#define XB_TOP      3328
#define XB_TOPGEN   3392
#define XCD_BAR_WORDS 3456
#define XB_SPIN_CAP (1u << 18)

__device__ __forceinline__ unsigned xb_ld(unsigned* p)              { return __hip_atomic_load(p, __ATOMIC_RELAXED, __HIP_MEMORY_SCOPE_AGENT); }
__device__ __forceinline__ unsigned xb_add(unsigned* p, unsigned v) { return __hip_atomic_fetch_add(p, v, __ATOMIC_RELAXED, __HIP_MEMORY_SCOPE_AGENT); }
__device__ __forceinline__ unsigned xb_xcc_id() { return (unsigned)__builtin_amdgcn_s_getreg((3 << 11) | 20) & 0xFu; }
#define XB_SPIN(cond, bar) do { unsigned _sp = 0; while (cond) { __builtin_amdgcn_s_sleep(1); \
    if ((++_sp & 255u) == 0u) { if (xb_ld(&(bar)[XB_TMO])) break; if (_sp > XB_SPIN_CAP) { atomicAdd(&(bar)[XB_TMO], 1u); break; } } } } while (0)

struct XcdBarrier {
    unsigned* bar; unsigned x;
    volatile LAS unsigned* st;
};

__device__ __forceinline__ XcdBarrier xcd_barrier_post(unsigned* bar, volatile LAS unsigned* st) {
    XcdBarrier b; b.bar = bar; b.x = xb_xcc_id(); b.st = st;
    if (threadIdx.x == 0) (void)xb_add(&bar[XB_XCNT(b.x)], 1u);
    return b;
}
__device__ __forceinline__ void xcd_barrier_complete(unsigned* bar, unsigned x, unsigned& nloc, unsigned& nx) {
    const unsigned G = gridDim.x * gridDim.y * gridDim.z;
    unsigned sum, cnt, mine, sp = 0u;
    for (;;) {
        sum = 0u; cnt = 0u; mine = 0u;
#pragma unroll
        for (unsigned j = 0; j < 16; ++j) { const unsigned c = xb_ld(&bar[XB_XCNT(j)]); sum += c; cnt += (c > 0u) ? 1u : 0u; mine = (j == x) ? c : mine; }
        if (sum == G) break;
        __builtin_amdgcn_s_sleep(1);
        if ((++sp & 255u) == 0u) { if (xb_ld(&bar[XB_TMO])) break; if (sp > XB_SPIN_CAP) { atomicAdd(&bar[XB_TMO], 1u); break; } }
    }
    nloc = mine > 0u ? mine : 1u; nx = cnt > 0u ? cnt : 1u;
}

__device__ __forceinline__ void xcd_barrier(const XcdBarrier& b) {
    asm volatile("s_waitcnt vmcnt(0)" ::: "memory");
    __syncthreads();
    if (threadIdx.x == 0) {
        unsigned* bar = b.bar;
        __builtin_amdgcn_s_waitcnt(0);
        unsigned nloc = b.st[0], nx = b.st[1];
        if (nloc == 0u) { xcd_barrier_complete(bar, b.x, nloc, nx); b.st[0] = nloc; b.st[1] = nx; }
        const unsigned old = xb_add(&bar[XB_XSUB(b.x)], 1u);
        const unsigned gen = old / nloc;
        if (old + 1u == (gen + 1u) * nloc) {
            __builtin_amdgcn_fence(__ATOMIC_RELEASE, "agent");
            asm volatile("s_waitcnt vmcnt(0)" ::: "memory");
            const unsigned og = xb_add(&bar[XB_TOP], 1u);
            const unsigned tg = og / nx;
            if (og + 1u == (tg + 1u) * nx) xb_add(&bar[XB_TOPGEN], 1u);
            else XB_SPIN(xb_ld(&bar[XB_TOPGEN]) == tg, bar);
            __builtin_amdgcn_fence(__ATOMIC_ACQUIRE, "agent");
            xb_add(&bar[XB_XGEN(b.x)], 1u);
            asm volatile("s_waitcnt vmcnt(0)" ::: "memory");
        } else {
            XB_SPIN(xb_ld(&bar[XB_XGEN(b.x)]) == gen, bar);
            __builtin_amdgcn_fence(__ATOMIC_ACQUIRE, "agent");
            asm volatile("s_waitcnt vmcnt(0)" ::: "memory");
        }
    }
    __syncthreads();
}
struct Ctx {
    unsigned char* lds;
    LAS unsigned char* ldsl;
    int tid, lane, wave, gw, ngw, G, bid;
    const float *x, *mem, *rp, *norm_mix, *w_in, *w_gate_up, *b_gate, *g_norm, *w_out, *norm_xattn, *norm_mem, *w_xq, *w_xkv, *w_xo, *norm_mlp, *w_up, *w_down, *norm_final;
    float* out; unsigned char* ws;
};
__device__ __forceinline__ float wave_sum(float v) {
#pragma unroll
    for (int o = 1; o < 64; o <<= 1) v += __shfl_xor(v, o);
    return v;
}
__device__ __forceinline__ float wave_max(float v) {
#pragma unroll
    for (int o = 1; o < 64; o <<= 1) v = fmaxf(v, __shfl_xor(v, o));
    return v;
}
__device__ __forceinline__ float bf2f(bf16 b) { return __builtin_bit_cast(float, (unsigned)b << 16); }
__device__ __forceinline__ float bflo(unsigned w) { return __builtin_bit_cast(float, w << 16); }
__device__ __forceinline__ float bfhi(unsigned w) { return __builtin_bit_cast(float, w & 0xffff0000u); }

__host__ __device__ __forceinline__ int rel_bucket(int d) {
    if (d < 16) return d;
    int b = 16;
    b += (d >= 19); b += (d >= 21); b += (d >= 24); b += (d >= 27); b += (d >= 31); b += (d >= 35); b += (d >= 40); b += (d >= 46);
    b += (d >= 52); b += (d >= 59); b += (d >= 67); b += (d >= 77); b += (d >= 87); b += (d >= 99); b += (d >= 113);
    return b;
}

__host__ __device__ __forceinline__ int win_row(int n) { return n < 2560 ? n : (n < 2576 ? 3072 + (n - 2560) : n - 16); }
template <bool MAPWIN>
__device__ __forceinline__ void p0_transpose_item(const float* W, int K, int N, bf16* WT, LAS float* scr, int item, int lane, const float* kgain = nullptr) {
    const int nblk = (N + 31) / 32, kb = item / nblk, nb = item % nblk, k0 = 64 * kb, n0 = 32 * nb;
    const int col = n0 + (lane & 31);
#pragma unroll 8
    for (int i = 0; i < 32; ++i) { const int kk = 2 * i + (lane >> 5); scr[kk * 33 + (lane & 31)] = col < N ? W[(size_t)(k0 + kk) * N + col] * (kgain ? kgain[k0 + kk] : 1.f) : 0.f; }
    LDS_WAIT(); asm volatile("" ::: "memory");
    const int c = lane & 7;
#pragma unroll
    for (int j = 0; j < 4; ++j) { const int n = (lane >> 3) + 8 * j; const LAS float* s = scr + (8 * c) * 33 + n;
        v4u o; o.x = pk2(s[0 * 33], s[1 * 33]); o.y = pk2(s[2 * 33], s[3 * 33]); o.z = pk2(s[4 * 33], s[5 * 33]); o.w = pk2(s[6 * 33], s[7 * 33]);
        if (n0 + n < N) { const int r = MAPWIN ? win_row(n0 + n) : (n0 + n); *(GAS v4u*)(WT + (size_t)r * K + k0 + 8 * c) = o; } }
    LDS_WAIT(); asm volatile("" ::: "memory");
}
__device__ __forceinline__ void rms_row_to_bf16(const float* xrow, const float* gain, bf16* orow, int lane) {
    const GAS f32x4* xr = (const GAS f32x4*)xrow + lane; const GAS f32x4* gr = (const GAS f32x4*)gain + lane;
    f32x4 v[4]; float s = 0.f;
#pragma unroll
    for (int j = 0; j < 4; ++j) { v[j] = xr[64 * j]; s += (v[j].x * v[j].x + v[j].y * v[j].y) + (v[j].z * v[j].z + v[j].w * v[j].w); }
    const float rstd = 1.f / sqrtf(wave_sum(s) * (1.f / 1024.f) + EPS);
    GAS unsigned long long* o8 = (GAS unsigned long long*)orow + lane;
#pragma unroll
    for (int j = 0; j < 4; ++j) { const f32x4 g = gr[64 * j];
        o8[64 * j] = (unsigned long long)pk2(v[j].x * rstd * g.x, v[j].y * rstd * g.y) | ((unsigned long long)pk2(v[j].z * rstd * g.z, v[j].w * rstd * g.w) << 32); }
}
__device__ __forceinline__ void p0_prologue(const Ctx& F) {
    LAS float* scr = (LAS float*)(F.ldsl + RING_OFF + F.wave * 16384);
    unsigned char* ws = F.ws;
    constexpr int I_IN = 16 * 97, I_SQ = 16 * 32, I_KV = 16 * 64, I_UP = 16 * 128, I_DN = 64 * 32;
    constexpr int NITEMS = I_IN + 3 * I_SQ + I_KV + I_UP + I_DN;
    for (int it = F.gw; it < NITEMS; it += F.ngw) {
        int r = it;
        if (r < I_IN) { p0_transpose_item<true>(F.w_in, 1024, 3088, (bf16*)(ws + WS_WIN), scr, r, F.lane); continue; } r -= I_IN;
        if (r < I_SQ) { p0_transpose_item<false>(F.w_out, 1024, 1024, (bf16*)(ws + WS_WOUT), scr, r, F.lane); continue; } r -= I_SQ;
        if (r < I_SQ) { p0_transpose_item<false>(F.w_xq, 1024, 1024, (bf16*)(ws + WS_WXQ), scr, r, F.lane, F.norm_xattn); continue; } r -= I_SQ;
        if (r < I_KV) { p0_transpose_item<false>(F.w_xkv, 1024, 2048, (bf16*)(ws + WS_WXKV), scr, r, F.lane); continue; } r -= I_KV;
        if (r < I_SQ) { p0_transpose_item<false>(F.w_xo, 1024, 1024, (bf16*)(ws + WS_WXO), scr, r, F.lane); continue; } r -= I_SQ;
        if (r < I_UP) { p0_transpose_item<false>(F.w_up, 1024, 4096, (bf16*)(ws + WS_WUP), scr, r, F.lane, F.norm_mlp); continue; } r -= I_UP;
        p0_transpose_item<false>(F.w_down, 4096, 1024, (bf16*)(ws + WS_WDN), scr, r, F.lane);
    }
    const int gt = F.bid * (NWAVES * 64) + F.tid, ngt = F.G * NWAVES * 64;
    {
        GAS v4u* z = (GAS v4u*)(ws + WS_WIN + (size_t)3088 * 2048);
        for (int i = gt; i < 240 * 128; i += ngt) z[i] = (v4u){0u, 0u, 0u, 0u};
    }
    {
        GAS v4u* z = (GAS v4u*)(ws + WS_SSQ1);
        for (int i = gt; i < (3 * 128 * 1024 + 256 * 1024) / 16; i += ngt) z[i] = (v4u){0u, 0u, 0u, 0u};
    }
    if (F.bid == 0) {
        float* bt = (float*)(ws + WS_BIAS);
        for (int i = F.tid; i < 8 * 128; i += NWAVES * 64) { const int h = i >> 7, d = i & 127; bt[i] = F.rp[rel_bucket(d) * 8 + h] * LOG2E; }
    }
    for (int m = F.gw; m < M; m += F.ngw) rms_row_to_bf16(F.x + (size_t)m * DM, F.norm_mix, (bf16*)(ws + WS_HA) + (size_t)m * DM, F.lane);
    for (int m = F.gw; m < MM; m += F.ngw) rms_row_to_bf16(F.mem + (size_t)m * DM, F.norm_mem, (bf16*)(ws + WS_MN) + (size_t)m * DM, F.lane);
}

__device__ __forceinline__ void moba_naive(const Ctx& F) {
    float* sc = (float*)(F.lds + F.wave * 4096);
    const bf16* QA = (const bf16*)(F.ws + WS_QA); const bf16* KA = (const bf16*)(F.ws + WS_KA); const bf16* VA = (const bf16*)(F.ws + WS_VA);
    const float* ksum = (const float*)(F.ws + WS_KSUM); const float* bias = (const float*)(F.ws + WS_BIAS);
    bf16* MIX = (bf16*)(F.ws + WS_MIX);
    const int lane = F.lane;
    for (int task = F.gw; task < M * AH; task += F.ngw) {
        const int h = task / M, row = task % M;
        const int b = row >> 11, t = row & 2047, qb = t >> 8;
        const bf16* qrow = QA + (size_t)row * AW + h * AHD;
        float q[64];
#pragma unroll
        for (int c = 0; c < 8; ++c) { const v4u w = *(const v4u*)(qrow + 8 * c);
            q[8 * c + 0] = bflo(w.x); q[8 * c + 1] = bfhi(w.x); q[8 * c + 2] = bflo(w.y); q[8 * c + 3] = bfhi(w.y);
            q[8 * c + 4] = bflo(w.z); q[8 * c + 5] = bfhi(w.z); q[8 * c + 6] = bflo(w.w); q[8 * c + 7] = bfhi(w.w); }
        const float qd = bf2f(qrow[lane]);
        float gate[8];
#pragma unroll
        for (int j = 0; j < 8; ++j) { const float g = wave_sum(qd * ksum[(size_t)(b * 8 + j) * 512 + h * 64 + lane]); gate[j] = (j < qb) ? g : -INFINITY; }
        unsigned sel = 0u;
#pragma unroll
        for (int r = 0; r < 3; ++r) { int best = -1; float bv = -INFINITY;
#pragma unroll
            for (int j = 0; j < 8; ++j) { const bool ok = !((sel >> j) & 1u) && (j < qb) && (gate[j] > bv); if (ok) { bv = gate[j]; best = j; } }
            if (best >= 0) sel |= 1u << best; }
        sel |= 1u << qb;
        sel = (unsigned)__builtin_amdgcn_readfirstlane((int)sel);
        int nb = 0; float mx = -INFINITY;
        for (int j = 0; j <= qb; ++j) {
            if (!((sel >> j) & 1u)) continue;
            for (int kk = 0; kk < 4; ++kk) {
                const int kpos = j * 256 + kk * 64 + lane; const int d = t - kpos;
                const bf16* krow = KA + (size_t)(b * SEQ + kpos) * AW + h * AHD;
                float s = 0.f;
#pragma unroll
                for (int c = 0; c < 8; ++c) { const v4u w = *(const v4u*)(krow + 8 * c);
                    s += q[8 * c + 0] * bflo(w.x) + q[8 * c + 1] * bfhi(w.x) + q[8 * c + 2] * bflo(w.y) + q[8 * c + 3] * bfhi(w.y)
                       + q[8 * c + 4] * bflo(w.z) + q[8 * c + 5] * bfhi(w.z) + q[8 * c + 6] * bflo(w.w) + q[8 * c + 7] * bfhi(w.w); }
                if (d >= 0) s += bias[h * 128 + (d < 127 ? d : 127)]; else s = -INFINITY;
                sc[nb * 256 + kk * 64 + lane] = s; mx = fmaxf(mx, s);
            }
            ++nb;
        }
        mx = wave_max(mx);
        float sum = 0.f;
        for (int i = lane; i < nb * 256; i += 64) { const float p = exp2f(sc[i] - mx); sc[i] = p; sum += p; }
        sum = wave_sum(sum);
        asm volatile("s_waitcnt lgkmcnt(0)" ::: "memory");
        float o = 0.f; int ib = 0;
        for (int j = 0; j <= qb; ++j) {
            if (!((sel >> j) & 1u)) continue;
            const bf16* vcol = VA + (size_t)(b * SEQ + j * 256) * AW + h * AHD + lane;
#pragma unroll 8
            for (int k = 0; k < 256; ++k) o += sc[ib * 256 + k] * bf2f(vcol[(size_t)k * AW]);
            ++ib;
        }
        MIX[(size_t)row * DM + h * AHD + lane] = (bf16)f2bf(o / sum);
        asm volatile("s_waitcnt lgkmcnt(0)" ::: "memory");
    }
}

__device__ __forceinline__ float log_sigmoid(float z) { return z < 0.f ? z - log1pf(expf(z)) : -log1pf(expf(-z)); }
__device__ __forceinline__ void gla_naive(const Ctx& F) {
    constexpr int TB = 16;
    float* qs = (float*)F.lds;
    float* ks = qs + TB * 64;
    float* as_ = ks + TB * 64;
    float* vs = as_ + TB * 64;
    float* gl = vs + TB * 128;
    float* part = gl + TB * 16;
    float* ob = part + 2 * 4 * 128;
    const bf16* QG = (const bf16*)(F.ws + WS_QG); const bf16* KG = (const bf16*)(F.ws + WS_KG); const bf16* VG = (const bf16*)(F.ws + WS_VG); const bf16* RG = (const bf16*)(F.ws + WS_RG);
    const float* GLR = (const float*)(F.ws + WS_GLR); bf16* MIX = (bf16*)(F.ws + WS_MIX);
    const int tid = F.tid, dv = tid & 127, g4 = tid >> 7;
    for (int chain = F.bid; chain < BATCH * GH; chain += F.G) {
        const int b = chain >> 2, hg = chain & 3;
        float S[16];
#pragma unroll
        for (int i = 0; i < 16; ++i) S[i] = 0.f;
        for (int t0 = 0; t0 < SEQ; t0 += TB) {
            const size_t r0 = (size_t)b * SEQ + t0;
            __syncthreads();
            for (int i = tid; i < TB * 64; i += 512) { const int tt = i >> 6, d = i & 63; qs[i] = bf2f(QG[(r0 + tt) * GKW + hg * 64 + d]); ks[i] = bf2f(KG[(r0 + tt) * GKW + hg * 64 + d]); }
            for (int i = tid; i < TB * 128; i += 512) { const int tt = i >> 7, d = i & 127; vs[i] = bf2f(VG[(r0 + tt) * GW + hg * 128 + d]); }
            if (tid < TB * 16) gl[tid] = GLR[(r0 + (tid >> 4)) * 16 + (tid & 15)];
            __syncthreads();
            for (int i = tid; i < TB * 64; i += 512) { const int tt = i >> 6, d = i & 63; float z = F.b_gate[hg * 64 + d];
#pragma unroll
                for (int r = 0; r < 16; ++r) z += gl[tt * 16 + r] * F.w_gate_up[r * GKW + hg * 64 + d];
                as_[i] = expf(log_sigmoid(z) * (1.0f / 16.0f)); }
            __syncthreads();
            for (int tt = 0; tt < TB; ++tt) {
                float po = 0.f; const float vv = vs[tt * 128 + dv];
#pragma unroll
                for (int i = 0; i < 16; ++i) { const int dk = 16 * g4 + i; S[i] = as_[tt * 64 + dk] * S[i] + ks[tt * 64 + dk] * vv; po += qs[tt * 64 + dk] * S[i]; }
                part[((tt & 1) * 4 + g4) * 128 + dv] = po;
                __syncthreads();
                if (tid < 128) ob[tt * 128 + tid] = (part[((tt & 1) * 4 + 0) * 128 + tid] + part[((tt & 1) * 4 + 1) * 128 + tid]) + (part[((tt & 1) * 4 + 2) * 128 + tid] + part[((tt & 1) * 4 + 3) * 128 + tid]);
            }
            __syncthreads();
#pragma unroll
            for (int k = 0; k < 2; ++k) { const int tt = 2 * F.wave + k; const size_t row = r0 + tt;
                const float o0 = ob[tt * 128 + F.lane], o1 = ob[tt * 128 + 64 + F.lane];
                const float rstd = 1.f / sqrtf(wave_sum(o0 * o0 + o1 * o1) * (1.f / 128.f) + EPS);
                const float r0v = bf2f(RG[row * GW + hg * 128 + F.lane]), r1v = bf2f(RG[row * GW + hg * 128 + 64 + F.lane]);
                const float y0 = o0 * rstd * F.g_norm[F.lane] * (r0v / (1.f + expf(-r0v))), y1 = o1 * rstd * F.g_norm[64 + F.lane] * (r1v / (1.f + expf(-r1v)));
                MIX[row * DM + AW + hg * 128 + F.lane] = (bf16)f2bf(y0); MIX[row * DM + AW + hg * 128 + 64 + F.lane] = (bf16)f2bf(y1); }
        }
        __syncthreads();
    }
}

__device__ __forceinline__ void xattn_naive(const Ctx& F) {
    float* qs = (float*)(F.lds + F.wave * 2048);
    float* sc = qs + 256;
    const bf16* QX = (const bf16*)(F.ws + WS_QX); const bf16* KX = (const bf16*)(F.ws + WS_KX); const bf16* VX = (const bf16*)(F.ws + WS_VX); bf16* OX = (bf16*)(F.ws + WS_OX);
    const int lane = F.lane;
    for (int task = F.gw; task < M * XH; task += F.ngw) {
        const int h = task / M, row = task % M, b = row >> 11;
        {   const unsigned long long w = *(const unsigned long long*)(QX + (size_t)row * DM + h * XHD + 4 * lane);
            qs[4 * lane + 0] = bflo((unsigned)w); qs[4 * lane + 1] = bfhi((unsigned)w); qs[4 * lane + 2] = bflo((unsigned)(w >> 32)); qs[4 * lane + 3] = bfhi((unsigned)(w >> 32)); }
        asm volatile("s_waitcnt lgkmcnt(0)" ::: "memory");
        float mx = -INFINITY;
        for (int kk = 0; kk < 4; ++kk) {
            const bf16* krow = KX + (size_t)(b * MEMLEN + kk * 64 + lane) * DM + h * XHD;
            float s = 0.f;
#pragma unroll 4
            for (int c = 0; c < 32; ++c) { const v4u w = *(const v4u*)(krow + 8 * c); const float* qq = qs + 8 * c;
                s += qq[0] * bflo(w.x) + qq[1] * bfhi(w.x) + qq[2] * bflo(w.y) + qq[3] * bfhi(w.y) + qq[4] * bflo(w.z) + qq[5] * bfhi(w.z) + qq[6] * bflo(w.w) + qq[7] * bfhi(w.w); }
            sc[kk * 64 + lane] = s; mx = fmaxf(mx, s);
        }
        mx = wave_max(mx);
        float sum = 0.f;
        for (int kk = 0; kk < 4; ++kk) { const float p = exp2f(sc[kk * 64 + lane] - mx); sc[kk * 64 + lane] = p; sum += p; }
        sum = wave_sum(sum);
        asm volatile("s_waitcnt lgkmcnt(0)" ::: "memory");
        float o0 = 0.f, o1 = 0.f, o2 = 0.f, o3 = 0.f;
        const bf16* vcol = VX + (size_t)(b * MEMLEN) * DM + h * XHD + 4 * lane;
#pragma unroll 8
        for (int k = 0; k < 256; ++k) { const unsigned long long w = *(const unsigned long long*)(vcol + (size_t)k * DM); const float p = sc[k];
            o0 += p * bflo((unsigned)w); o1 += p * bfhi((unsigned)w); o2 += p * bflo((unsigned)(w >> 32)); o3 += p * bfhi((unsigned)(w >> 32)); }
        const float inv = 1.f / sum;
        *(unsigned long long*)(OX + (size_t)row * DM + h * XHD + 4 * lane) = (unsigned long long)pk2(o0 * inv, o1 * inv) | ((unsigned long long)pk2(o2 * inv, o3 * inv) << 32);
        asm volatile("s_waitcnt lgkmcnt(0)" ::: "memory");
    }
}

__device__ __forceinline__ void final_norm(const Ctx& F, const bf16* in, float* outp) {
    const float* ssq = (const float*)(F.ws + WS_SSQ3);
    for (int m = F.gw; m < M; m += F.ngw) {
        const GAS v4u* xr = (const GAS v4u*)(in + (size_t)m * DM) + F.lane; GAS f32x4* xo = (GAS f32x4*)(outp + (size_t)m * DM) + 2 * F.lane; const GAS f32x4* gr = (const GAS f32x4*)F.norm_final + 2 * F.lane;
        const float rstd = 1.f / sqrtf(ssq[m] * (1.f / 1024.f) + EPS);
#pragma unroll
        for (int j = 0; j < 2; ++j) { const v4u w = xr[64 * j]; const f32x4 g0 = gr[128 * j], g1 = gr[128 * j + 1];
            xo[128 * j] = (f32x4){bflo(w.x) * rstd * g0.x, bfhi(w.x) * rstd * g0.y, bflo(w.y) * rstd * g0.z, bfhi(w.y) * rstd * g0.w};
            xo[128 * j + 1] = (f32x4){bflo(w.z) * rstd * g1.x, bfhi(w.z) * rstd * g1.y, bflo(w.w) * rstd * g1.z, bfhi(w.w) * rstd * g1.w}; }
    }
}

constexpr int NPHASE = 10;
#ifndef PROBE
#define PROBE -1
#endif
struct Args { const float* in[18]; float* out; unsigned char* ws; int ph_lo, ph_hi, li, pad; };
__global__ void __launch_bounds__(NWAVES * 64, 2) mk_fwd(Args args) {
    extern __shared__ __attribute__((aligned(16))) unsigned char lds[];
    Ctx F;
    F.lds = lds; F.ldsl = (LAS unsigned char*)lds;
    F.tid = threadIdx.x; F.lane = F.tid & 63; F.wave = __builtin_amdgcn_readfirstlane(F.tid >> 6);
    F.G = gridDim.x; F.bid = blockIdx.x; F.gw = F.bid * NWAVES + F.wave; F.ngw = F.G * NWAVES;
    F.x = args.in[0]; F.mem = args.in[1]; F.rp = args.in[2]; F.norm_mix = args.in[3]; F.w_in = args.in[4]; F.w_gate_up = args.in[5]; F.b_gate = args.in[6]; F.g_norm = args.in[7];
    F.w_out = args.in[8]; F.norm_xattn = args.in[9]; F.norm_mem = args.in[10]; F.w_xq = args.in[11]; F.w_xkv = args.in[12]; F.w_xo = args.in[13]; F.norm_mlp = args.in[14];
    F.w_up = args.in[15]; F.w_down = args.in[16]; F.norm_final = args.in[17];
    F.out = args.out; F.ws = args.ws;
    unsigned char* ws = args.ws;
    volatile LAS unsigned* MISC = (volatile LAS unsigned*)(F.ldsl + MISC_OFF);
    for (int u = F.tid; u < (LDS_BYTES - LDSCTL_OFF) / 4; u += NWAVES * 64) ((LAS unsigned*)(F.ldsl + LDSCTL_OFF))[u] = 0u;
    __syncthreads();
    const int lo = args.ph_lo, hi = args.ph_hi;
    XcdBarrier bar; bar.bar = (unsigned*)(ws + WS_CTL) + CW_BAR + args.li * XCD_BAR_WORDS; bar.x = 0; bar.st = nullptr;
    bar = xcd_barrier_post((unsigned*)(ws + WS_CTL) + CW_BAR + args.li * XCD_BAR_WORDS, MISC + 8);
#define IN(k) (lo <= (k) && (k) < hi)
#define SEAM(k) do { if (IN(k) && IN((k) + 1)) xcd_barrier(bar); } while (0)
    float* ssq1 = (float*)(ws + WS_SSQ1); float* ssq2 = (float*)(ws + WS_SSQ2); float* ssq3 = (float*)(ws + WS_SSQ3);
    bf16* HA = (bf16*)(ws + WS_HA);

    float* ssqD = (float*)(ws + WS_SSQD);
    if (IN(0)) { p0_prologue(F); if (PROBE == 0) { xcd_barrier(bar); p0_prologue(F); } SEAM(0); }

    if (IN(1)) for (int rep_ = 0; rep_ < (PROBE == 1 ? 2 : 1); ++rep_) {
        if (rep_) xcd_barrier(bar);
        {   pg8::Gemm g{HA, (const bf16*)(ws + WS_WIN), M, NIN, DM}; pg8::StaticOrder S; S.init(M, NIN, F.G, F.bid);
            pg8::EpiInProj E{(bf16*)(ws + WS_QA), (bf16*)(ws + WS_KA), (bf16*)(ws + WS_VA), (bf16*)(ws + WS_QG), (bf16*)(ws + WS_KG), (bf16*)(ws + WS_VG), (bf16*)(ws + WS_RG),
                             (float*)(ws + WS_GLR), (float*)(ws + WS_KSUM), C2A, 0.125f};
            pg8::gemm_phase<pg8::EpiInProj, pg8::StaticOrder, PG8_ALIGN, PG8_SP2>(F.ldsl + RING_OFF, g, S, E); }
        {   pg8::Gemm g{(const bf16*)(ws + WS_MN), (const bf16*)(ws + WS_WXKV), MM, 2048, DM}; pg8::StaticOrder S; S.init(MM, 2048, F.G, F.bid);
            pg8::EpiSplitBf16 E{(bf16*)(ws + WS_KX), (bf16*)(ws + WS_VX), 4, DM};
            pg8::gemm_phase<pg8::EpiSplitBf16, pg8::StaticOrder, PG8_ALIGN, PG8_SP2>(F.ldsl + RING_OFF, g, S, E); }
    }
    SEAM(1);
    if (IN(2)) {
        {   float* GOI = F.out; float* GU = F.out + (size_t)16 * 1024 * 1024;
            for (int rep_ = 0; rep_ < (PROBE == 2 ? 2 : 1); ++rep_) {
            attn_body::gla::gla_pass1((char*)lds + RING_OFF, (int)F.G, (int)F.bid, (const attn_body::bf16*)(ws + WS_QG), (const attn_body::bf16*)(ws + WS_KG), (const attn_body::bf16*)(ws + WS_VG),
                                      (const float*)(ws + WS_GLR), F.w_gate_up, F.b_gate, (attn_body::bf16*)(ws + WS_QE), (float*)(ws + WS_DEC), GU, GOI);
            xcd_barrier(bar); }
            if (PROBE == 10) {
                if (F.bid < BATCH * GH)
                    attn_body::gla::gla_chain((char*)lds + RING_OFF, (int)F.bid, (const attn_body::bf16*)(ws + WS_QE), (const float*)(ws + WS_DEC), GU, GOI, (const attn_body::bf16*)(ws + WS_RG), F.g_norm, (attn_body::bf16*)(ws + WS_MIX));
                xcd_barrier(bar);
            } else
            if (F.bid < BATCH * GH)
                attn_body::gla::gla_chain((char*)lds + RING_OFF, (int)F.bid, (const attn_body::bf16*)(ws + WS_QE), (const float*)(ws + WS_DEC), GU, GOI, (const attn_body::bf16*)(ws + WS_RG), F.g_norm, (attn_body::bf16*)(ws + WS_MIX));
        }
        const attn_body::AttnTensors AT{(const attn_body::bf16*)(ws + WS_QA), (const attn_body::bf16*)(ws + WS_KA), (const attn_body::bf16*)(ws + WS_VA), (attn_body::bf16*)(ws + WS_MIX),
                                        (const float*)(ws + WS_KSUM), (const float*)(ws + WS_BIAS)};
        for (int rep_ = 0; rep_ < (PROBE == 11 ? 2 : 1); ++rep_) {
            if (rep_) xcd_barrier(bar);
            volatile LAS unsigned* qw = MISC + 16; gu32* ctl = (gu32*)(ws + WS_CTL) + 32 * rep_;
            const int myx = F.bid & 7;
            for (int pass = 0; pass < 8; ++pass) { const int x = (myx + pass) & 7;
                for (;;) {
                    __syncthreads();
                    if (F.tid == 0) qw[0] = __hip_atomic_fetch_add(ctl + CW_Q + 64 * x, 1u, RLX_AGENT);
                    __syncthreads();
                    const unsigned u = (unsigned)__builtin_amdgcn_readfirstlane((int)qw[0]);
                    if (u >= 128u) break;
                    const int qb = 7 - (int)(u >> 4), bh = 8 * (int)(u & 15u) + x;
                    attn_body::attn_unit<8>(bh >> 3, bh & 7, qb, AT.Q, AT.K, AT.V, AT.O, AT.ksum, AT.biasl2, (char*)lds + RING_OFF);
                }
            }
        }
        SEAM(2);
    }
    if (IN(3)) {
        pg8::Gemm g{(const bf16*)(ws + WS_MIX), (const bf16*)(ws + WS_WOUT), M, DM, DM}; pg8::StaticOrder S; S.init(M, DM, F.G, F.bid);
        pg8::EpiResidual<true> E{F.x, HA, ssq1};
        pg8::gemm_phase<pg8::EpiResidual<true>, pg8::StaticOrder, PG8_ALIGN, PG8_SP2>(F.ldsl + RING_OFF, g, S, E);
        if (PROBE == 3) { xcd_barrier(bar); pg8::EpiResidual<true> E2{F.x, HA, ssqD}; pg8::gemm_phase<pg8::EpiResidual<true>, pg8::StaticOrder, PG8_ALIGN, PG8_SP2>(F.ldsl + RING_OFF, g, S, E2); }
        SEAM(3);
    }
    if (IN(4)) {
        pg8::Gemm g{HA, (const bf16*)(ws + WS_WXQ), M, DM, DM}; pg8::StaticOrder S; S.init(M, DM, F.G, F.bid);
        pg8::EpiRowScale<0> E{(bf16*)(ws + WS_QX), DM, ssq1, EPS, C2X};
        pg8::gemm_phase<pg8::EpiRowScale<0>, pg8::StaticOrder, PG8_ALIGN, PG8_SP2>(F.ldsl + RING_OFF, g, S, E);
        if (PROBE == 4) { xcd_barrier(bar); pg8::gemm_phase<pg8::EpiRowScale<0>, pg8::StaticOrder, PG8_ALIGN, PG8_SP2>(F.ldsl + RING_OFF, g, S, E); }
        SEAM(4);
    }
    if (IN(5)) for (int rep_ = 0; rep_ < (PROBE == 5 ? 2 : 1); ++rep_) {
        if (rep_) xcd_barrier(bar);
        attn_body::xa::xattn_phase((char*)lds + RING_OFF, (const attn_body::bf16*)(ws + WS_QX), (const attn_body::bf16*)(ws + WS_KX), (const attn_body::bf16*)(ws + WS_VX), (attn_body::bf16*)(ws + WS_OX), (int)F.G, (int)F.bid);
    }
    SEAM(5);
    if (IN(6)) {
        pg8::Gemm g{(const bf16*)(ws + WS_OX), (const bf16*)(ws + WS_WXO), M, DM, DM}; pg8::StaticOrder S; S.init(M, DM, F.G, F.bid);
        pg8::EpiResidual<false> E{HA, HA, ssq2};
        pg8::gemm_phase<pg8::EpiResidual<false>, pg8::StaticOrder, PG8_ALIGN, PG8_SP2>(F.ldsl + RING_OFF, g, S, E);
        if (PROBE == 6) { xcd_barrier(bar); pg8::EpiResidual<false> E2{HA, (bf16*)(ws + WS_MIX), ssqD}; pg8::gemm_phase<pg8::EpiResidual<false>, pg8::StaticOrder, PG8_ALIGN, PG8_SP2>(F.ldsl + RING_OFF, g, S, E2); }
        SEAM(6);
    }
    if (IN(7)) {
        pg8::Gemm g{HA, (const bf16*)(ws + WS_WUP), M, FF, DM}; pg8::StaticOrder S; S.init(M, FF, F.G, F.bid);
        pg8::EpiRowScale<1> E{(bf16*)(ws + WS_U), FF, ssq2, EPS, 1.0f};
        pg8::gemm_phase<pg8::EpiRowScale<1>, pg8::StaticOrder, PG8_ALIGN, PG8_SP2>(F.ldsl + RING_OFF, g, S, E);
        if (PROBE == 7) { xcd_barrier(bar); pg8::gemm_phase<pg8::EpiRowScale<1>, pg8::StaticOrder, PG8_ALIGN, PG8_SP2>(F.ldsl + RING_OFF, g, S, E); }
        SEAM(7);
    }
    if (IN(8)) {
        pg8::Gemm g{(const bf16*)(ws + WS_U), (const bf16*)(ws + WS_WDN), M, DM, FF}; pg8::StaticOrder S; S.init(M, DM, F.G, F.bid);
        pg8::EpiResidual<false> E{HA, HA, ssq3};
        pg8::gemm_phase<pg8::EpiResidual<false>, pg8::StaticOrder, PG8_ALIGN, PG8_SP2>(F.ldsl + RING_OFF, g, S, E);
        if (PROBE == 8) { xcd_barrier(bar); pg8::EpiResidual<false> E2{HA, (bf16*)(ws + WS_MIX), ssqD}; pg8::gemm_phase<pg8::EpiResidual<false>, pg8::StaticOrder, PG8_ALIGN, PG8_SP2>(F.ldsl + RING_OFF, g, S, E2); }
        SEAM(8);
    }
    if (IN(9)) { final_norm(F, HA, F.out); if (PROBE == 9) { xcd_barrier(bar); final_norm(F, HA, (float*)(ws + WS_MIX)); } }
#undef IN
#undef SEAM
}

#ifndef MK_CUTS
#define MK_CUTS 0x0
#endif
extern "C" void kernel_launch(void* const* d_in, const int* in_sizes, int n_in, void* d_out, int out_size, void* d_ws, size_t ws_size, hipStream_t stream) {
    static int grid = 0;
    if (grid == 0) {
        if (n_in != 18 || out_size != M * DM || ws_size < WS_END) { fprintf(stderr, "kernel_launch: unexpected shapes (n_in %d out %d ws %zu)\n", n_in, out_size, ws_size); grid = -1; return; }
        int dev = 0, cus = 0;
        if (hipGetDevice(&dev) != hipSuccess || hipDeviceGetAttribute(&cus, hipDeviceAttributeMultiprocessorCount, dev) != hipSuccess) { grid = -1; return; }
        if (hipFuncSetAttribute((const void*)mk_fwd, hipFuncAttributeMaxDynamicSharedMemorySize, LDS_BYTES) != hipSuccess) { fprintf(stderr, "kernel_launch: hipFuncSetAttribute failed\n"); grid = -1; return; }
        (void)hipGetLastError();
        grid = cus;
    }
    if (grid < 0) return;
    (void)hipMemsetAsync((char*)d_ws + WS_CTL, 0, CTL_ZERO_BYTES, stream);
    Args a{};
    for (int i = 0; i < 18; ++i) a.in[i] = (const float*)d_in[i];
    a.out = (float*)d_out; a.ws = (unsigned char*)d_ws;
    int lo = 0, li = 0;
    for (int k = 0; k < NPHASE; ++k) {
        if (k == NPHASE - 1 || ((MK_CUTS >> k) & 1)) {
            a.ph_lo = lo; a.ph_hi = k + 1; a.li = li++;
            hipLaunchKernelGGL(mk_fwd, dim3(grid), dim3(NWAVES * 64), LDS_BYTES, stream, a);
            lo = k + 1;
        }
    }
}
```
